# Optimizing an MI355X kernel written in HIP

```python
import math
import jax
import jax.numpy as jnp
from jax import lax
import numpy as np

D_MODEL = 1024
BATCH = 8
SEQ = 4096
DEPTH = 4

CTX_LEN = 256
GRID_W = 64
N_MOD = 6
CONV_W = 512
CONV_K = 3
SSM_W = 512
SSM_GROUP = 16
SSM_GROUPS = SSM_W // SSM_GROUP
SSM_STATE = 64
NA_HEADS = 8
NA_HEAD_DIM = 64
NA_W = NA_HEADS * NA_HEAD_DIM
WIN_H = 8
WIN_W = 16
MLP_HIDDEN = 4 * D_MODEL
N_BRANCH = 3
IN_SIZES = (CONV_W, CONV_W, CONV_W, SSM_W, NA_W, NA_W, NA_W, D_MODEL, D_MODEL, D_MODEL)
IN_OFF = tuple(sum(IN_SIZES[:i]) for i in range(len(IN_SIZES) + 1))
IN_PROJ_W = IN_OFF[-1]
RMS_EPS = 1e-6
NEG_INF = -1e30
S5_MIN_DECAY = 1e-4

kernel_name = 'hybrid_conv_s5_natten_prefix_dit_trunk'


def rmsnorm(x, g):
    xf = x.astype(jnp.float32)
    y = xf * lax.rsqrt(jnp.mean(xf * xf, axis=-1, keepdims=True) + RMS_EPS)
    return (y * g.astype(jnp.float32)).astype(x.dtype)


def modulate(h, shift, scale):
    return h * (1.0 + scale) + shift


def adaln(cond, w_mod, b_mod, n):
    m = jax.nn.silu(cond) @ w_mod[:, :n * D_MODEL] + b_mod[:n * D_MODEL]
    m = m.reshape(-1, n, D_MODEL)
    return [m[:, i:i + 1, :] for i in range(n)]


def split_in(p):
    return [p[..., IN_OFF[i]:IN_OFF[i + 1]] for i in range(len(IN_SIZES))]


def depthwise_conv3(u, w):
    up = jnp.pad(u, ((0, 0), (1, 1), (0, 0)))
    return up[:, :-2] * w[0] + up[:, 1:-1] * w[1] + up[:, 2:] * w[2]


def short_conv_branch(xa, b_gate, c_gate, conv_w, w_out):
    return (b_gate * depthwise_conv3(c_gate * xa, conv_w)) @ w_out


def s5_discretize(lam_re, lam_im, log_step, b_re, b_im, c_re, c_im):
    f32 = jnp.float32
    lam = lax.complex(jnp.minimum(lam_re.astype(f32), -S5_MIN_DECAY), lam_im.astype(f32))
    lam_dt = lam * jnp.exp(log_step.astype(f32))[..., None]
    lam_bar = jnp.exp(lam_dt)
    b_bar = ((lam_bar - 1.0) / lam)[..., None] * lax.complex(b_re.astype(f32), b_im.astype(f32))
    c_mat = lax.complex(c_re.astype(f32), c_im.astype(f32))
    return lam_dt, lam_bar, b_bar, c_mat


def s5_drive(u, b_bar_d):
    ug = u.astype(jnp.float32).reshape(u.shape[:2] + (SSM_GROUPS, SSM_GROUP))
    return jnp.einsum('blgn,gpn->blgp', ug.astype(jnp.complex64), b_bar_d)


def _scan_combine(left, right):
    a_l, b_l = left
    a_r, b_r = right
    return a_r * a_l, a_r * b_l + b_r


def diag_scan(a, bu):
    a_seq = jnp.broadcast_to(a, bu.shape)
    return lax.associative_scan(_scan_combine, (a_seq, bu), axis=1)[1]


def s5_context_states(uc, s5p):
    _, lam_bar, b_bar, _ = s5p
    h_f = diag_scan(lam_bar[0], s5_drive(uc, b_bar[0]))
    h_b = jnp.flip(diag_scan(lam_bar[1], jnp.flip(s5_drive(uc, b_bar[1]), 1)), 1)
    return h_f, h_b


def s5_latent_states(ux, s5p, h0_f, h0_b):
    lam_dt, lam_bar, b_bar, _ = s5p
    steps = jnp.arange(1, ux.shape[1] + 1, dtype=jnp.float32)[:, None, None]
    h_f = diag_scan(lam_bar[0], s5_drive(ux, b_bar[0])) + jnp.exp(lam_dt[0] * steps) * h0_f[:, None]
    h_b = diag_scan(lam_bar[1], jnp.flip(s5_drive(ux, b_bar[1]), 1)) + jnp.exp(lam_dt[1] * steps) * h0_b[:, None]
    return h_f, jnp.flip(h_b, 1)


def s5_output(u, h_f, h_b, c_mat, d_skip, w_glu_a, w_glu_b):
    y = jnp.real(jnp.einsum('blgp,gnp->blgn', h_f, c_mat[0]) + jnp.einsum('blgp,gnp->blgn', h_b, c_mat[1]))
    y = y.reshape(u.shape).astype(u.dtype) + d_skip * u
    g = jax.nn.gelu(y)
    return (g @ w_glu_a) * jax.nn.sigmoid(g @ w_glu_b)


def to_heads(t):
    return t.reshape(t.shape[:2] + (NA_HEADS, NA_HEAD_DIM))


def context_attention(qc, kc, vc):
    scale = NA_HEAD_DIM ** -0.5
    s = jnp.einsum('bqhd,bkhd->bhqk', to_heads(qc), to_heads(kc)).astype(jnp.float32) * scale
    p = jax.nn.softmax(s, axis=-1).astype(vc.dtype)
    o = jnp.einsum('bhqk,bkhd->bqhd', p, to_heads(vc))
    return o.reshape(qc.shape[:2] + (NA_W,))


def neighbourhood_attention(q, k, v, kc, vc, rpb):
    bsz, seq = q.shape[:2]
    rows = seq // GRID_W
    win_h = min(WIN_H, rows)
    n_loc = win_h * GRID_W
    scale = NA_HEAD_DIM ** -0.5
    grid = (bsz, rows, GRID_W, NA_HEADS, NA_HEAD_DIM)
    qg, kg, vg = q.reshape(grid), k.reshape(grid), v.reshape(grid)
    kch, vch = to_heads(kc), to_heads(vc)
    col = jnp.arange(GRID_W)
    col_start = jnp.clip(col - WIN_W // 2, 0, GRID_W - WIN_W)
    key_in = (col[None, :] >= col_start[:, None]) & (col[None, :] < col_start[:, None] + WIN_W)
    dc_idx = jnp.clip(col[None, :] - col[:, None] + WIN_W - 1, 0, 2 * WIN_W - 2)
    rpb_cols = rpb[:, :, dc_idx]

    def row_block(r):
        r0 = jnp.clip(r - win_h // 2, 0, rows - win_h)
        q_r = lax.dynamic_index_in_dim(qg, r, axis=1, keepdims=False)
        k_r = lax.dynamic_slice_in_dim(kg, r0, win_h, axis=1)
        v_r = lax.dynamic_slice_in_dim(vg, r0, win_h, axis=1)
        dr = r0 + jnp.arange(win_h) - r
        bias = jnp.transpose(rpb_cols[:, dr + WIN_H - 1], (0, 2, 1, 3))
        s_loc = jnp.einsum('bqhd,bwkhd->bhqwk', q_r, k_r).astype(jnp.float32) * scale + bias
        s_loc = jnp.where(key_in[:, None, :], s_loc, NEG_INF)
        s_ctx = jnp.einsum('bqhd,bchd->bhqc', q_r, kch).astype(jnp.float32) * scale
        s = jnp.concatenate([s_loc.reshape(bsz, NA_HEADS, GRID_W, n_loc), s_ctx], axis=-1)
        p = jax.nn.softmax(s, axis=-1).astype(v.dtype)
        p_loc = p[..., :n_loc].reshape(bsz, NA_HEADS, GRID_W, win_h, GRID_W)
        return (jnp.einsum('bhqwk,bwkhd->bqhd', p_loc, v_r)
                + jnp.einsum('bhqc,bchd->bqhd', p[..., n_loc:], vch))

    o = lax.map(row_block, jnp.arange(rows))
    return jnp.moveaxis(o, 0, 1).reshape(bsz, seq, NA_W)


def gated_merge(ya, yb, yc, ga, gb, gc, w_out):
    return (jax.nn.sigmoid(ga) * ya + jax.nn.sigmoid(gb) * yb + jax.nn.sigmoid(gc) * yc) @ w_out


def sqrelu_mlp(h, w1, w2):
    return jnp.square(jax.nn.relu(h @ w1)) @ w2


def setup_inputs(seed: int = 0) -> dict:
    key = jax.random.key(seed)
    ks = iter(jax.random.split(key, 32))
    f32 = jnp.float32

    def nrm(shape, scale):
        return jax.random.normal(next(ks), shape, f32) * scale

    L, G, P, N = DEPTH, SSM_GROUPS, SSM_STATE, SSM_GROUP
    x = nrm((BATCH, SEQ, D_MODEL), 1.0)
    c = nrm((BATCH, D_MODEL), 1.0)
    ctx = nrm((BATCH, CTX_LEN, D_MODEL), 1.0)
    c_ctx = nrm((D_MODEL,), 1.0)
    w_mod = nrm((L, D_MODEL, N_MOD * D_MODEL), D_MODEL ** -0.5)
    b_mod = nrm((L, N_MOD * D_MODEL), 0.01)
    norm1_g = 1.0 + nrm((L, D_MODEL), 0.01)
    w_in = nrm((L, D_MODEL, IN_PROJ_W), D_MODEL ** -0.5)
    conv_w = nrm((L, CONV_K, CONV_W), CONV_K ** -0.5)
    conv_out = nrm((L, CONV_W, D_MODEL), CONV_W ** -0.5)
    s5_lam_re = -0.5 + nrm((L, 2, G, P), 0.01)
    s5_lam_im = math.pi * jnp.arange(P, dtype=f32) + nrm((L, 2, G, P), 0.01)
    s5_log_step = jax.random.uniform(next(ks), (L, 2, G), f32, math.log(1e-3), math.log(1e-1))
    s5_b_re = nrm((L, 2, G, P, N), (2 * N) ** -0.5)
    s5_b_im = nrm((L, 2, G, P, N), (2 * N) ** -0.5)
    s5_c_re = nrm((L, 2, G, N, P), (2 * P) ** -0.5)
    s5_c_im = nrm((L, 2, G, N, P), (2 * P) ** -0.5)
    s5_d = nrm((L, SSM_W), 1.0)
    s5_glu_a = nrm((L, SSM_W, D_MODEL), SSM_W ** -0.5)
    s5_glu_b = nrm((L, SSM_W, D_MODEL), SSM_W ** -0.5)
    na_rpb = nrm((L, NA_HEADS, 2 * WIN_H - 1, 2 * WIN_W - 1), 0.1)
    na_out = nrm((L, NA_W, D_MODEL), NA_W ** -0.5)
    w_out = nrm((L, D_MODEL, D_MODEL), D_MODEL ** -0.5)
    norm2_g = 1.0 + nrm((L, D_MODEL), 0.01)
    mlp_w1 = nrm((L, D_MODEL, MLP_HIDDEN), D_MODEL ** -0.5)
    mlp_w2 = nrm((L, MLP_HIDDEN, D_MODEL), MLP_HIDDEN ** -0.5)
    final_norm_g = 1.0 + nrm((D_MODEL,), 0.01)
    return {'x': x, 'c': c, 'ctx': ctx, 'c_ctx': c_ctx, 'w_mod': w_mod, 'b_mod': b_mod,
            'norm1_g': norm1_g, 'w_in': w_in, 'conv_w': conv_w, 'conv_out': conv_out,
            's5_lam_re': s5_lam_re, 's5_lam_im': s5_lam_im, 's5_log_step': s5_log_step,
            's5_b_re': s5_b_re, 's5_b_im': s5_b_im, 's5_c_re': s5_c_re, 's5_c_im': s5_c_im,
            's5_d': s5_d, 's5_glu_a': s5_glu_a, 's5_glu_b': s5_glu_b, 'na_rpb': na_rpb,
            'na_out': na_out, 'w_out': w_out, 'norm2_g': norm2_g, 'mlp_w1': mlp_w1,
            'mlp_w2': mlp_w2, 'final_norm_g': final_norm_g}


def reference(x, c, ctx, c_ctx, w_mod, b_mod, norm1_g, w_in, conv_w, conv_out,
              s5_lam_re, s5_lam_im, s5_log_step, s5_b_re, s5_b_im, s5_c_re, s5_c_im,
              s5_d, s5_glu_a, s5_glu_b, na_rpb, na_out, w_out, norm2_g, mlp_w1, mlp_w2,
              final_norm_g):
    cx = ctx
    for l in range(DEPTH):
        ctx_out = l < DEPTH - 1
        mx = adaln(c, w_mod[l], b_mod[l], N_MOD)
        mc = adaln(c_ctx, w_mod[l], b_mod[l], N_MOD if ctx_out else 2)
        hx = modulate(rmsnorm(x, norm1_g[l]), mx[0], mx[1])
        hc = modulate(rmsnorm(cx, norm1_g[l]), mc[0], mc[1])
        s5p = s5_discretize(s5_lam_re[l], s5_lam_im[l], s5_log_step[l],
                            s5_b_re[l], s5_b_im[l], s5_c_re[l], s5_c_im[l])
        xa, xb, xcg, ux, qx, kx, vx, gax, gbx, gcx = split_in(hx @ w_in[l])
        if ctx_out:
            ca, cb, ccg, uc, qc, kc, vc, gac, gbc, gcc = split_in(hc @ w_in[l])
        else:
            uc = hc @ w_in[l][:, IN_OFF[3]:IN_OFF[4]]
            kc, vc = jnp.split(hc @ w_in[l][:, IN_OFF[5]:IN_OFF[7]], 2, axis=-1)
        hc_f, hc_b = s5_context_states(uc, s5p)
        hx_f, hx_b = s5_latent_states(ux, s5p, hc_f[:, -1], hc_b[:, 0])
        ya = short_conv_branch(xa, xb, xcg, conv_w[l], conv_out[l])
        yb = s5_output(ux, hx_f, hx_b, s5p[3], s5_d[l], s5_glu_a[l], s5_glu_b[l])
        yc = neighbourhood_attention(qx, kx, vx, kc, vc, na_rpb[l]) @ na_out[l]
        x_mix = gated_merge(ya, yb, yc, gax, gbx, gcx, w_out[l])
        if ctx_out:
            ya_c = short_conv_branch(ca, cb, ccg, conv_w[l], conv_out[l])
            yb_c = s5_output(uc, hc_f, hc_b, s5p[3], s5_d[l], s5_glu_a[l], s5_glu_b[l])
            yc_c = context_attention(qc, kc, vc) @ na_out[l]
            c_mix = gated_merge(ya_c, yb_c, yc_c, gac, gbc, gcc, w_out[l])
            cx = cx + mc[2] * c_mix
            cx = cx + mc[5] * sqrelu_mlp(modulate(rmsnorm(cx, norm2_g[l]), mc[3], mc[4]),
                                         mlp_w1[l], mlp_w2[l])
        x = x + mx[2] * x_mix
        x = x + mx[5] * sqrelu_mlp(modulate(rmsnorm(x, norm2_g[l]), mx[3], mx[4]),
                                   mlp_w1[l], mlp_w2[l])
    return rmsnorm(x, final_norm_g)
```

```cpp
#include <hip/hip_runtime.h>
#include <hip/hip_cooperative_groups.h>
#include <cstdio>
#include <cstdint>
namespace cg = cooperative_groups;

#ifndef ONE_LAUNCH
#define ONE_LAUNCH 1
#endif
#ifndef GEMM_SP2
#define GEMM_SP2 1
#endif

#define LAS __attribute__((address_space(3)))
typedef unsigned short bf16_t;
typedef short bf16x8 __attribute__((ext_vector_type(8)));
typedef float f32x4 __attribute__((ext_vector_type(4)));
typedef float f32x2 __attribute__((ext_vector_type(2)));
typedef unsigned u32x4 __attribute__((ext_vector_type(4)));
typedef unsigned u32x2 __attribute__((ext_vector_type(2)));
typedef float f32x16 __attribute__((ext_vector_type(16)));

constexpr int DM = 1024, NB = 8, SEQ = 4096, CTXL = 256, TPB = 4352  , MTOK = NB * TPB  , DEPTH = 4;
constexpr int INW = 6656, HID = 4096;
constexpr int TCH = 32  , CPB = TPB / TCH  , NCR = NB * CPB  ;
constexpr int NPHASE = 1 + DEPTH * 10 + 1;

constexpr size_t OFF_XC = 0;
constexpr size_t OFF_MODS = OFF_XC + 8388608;
constexpr size_t OFF_AP = OFF_MODS + 884736;
constexpr size_t OFF_BB = OFF_AP + 4325376;
constexpr size_t OFF_KTAB = OFF_BB + 2097152;
constexpr size_t OFF_WA = OFF_KTAB + 2097152;
constexpr size_t WA_WIN = 0, WA_CONV = 13631488, WA_GLUA = WA_CONV + 1048576, WA_GLUB = WA_GLUA + 1048576, WA_NA = WA_GLUB + 1048576, WA_WOUT = WA_NA + 1048576, WA_SIZE = WA_WOUT + 2097152;
constexpr size_t OFF_WB = OFF_WA + WA_SIZE;
constexpr size_t OFF_HN = OFF_WB + 16777216;
constexpr size_t OFF_A2 = OFF_HN + 71303168;
constexpr size_t OFF_BTY = OFF_A2 + 53477376;
constexpr size_t OFF_WET = OFF_BTY + 25165824;
constexpr size_t OFF_R1 = OFF_WET + 8388608;
constexpr size_t OFF_R2 = OFF_R1 + 213909504;
constexpr size_t SZ_ACT = 35651584;
constexpr int PALD = 2048;
constexpr size_t OFF_KH = OFF_R1 + (size_t)MTOK * PALD * 2;
constexpr size_t OFF_VT = OFF_KH + SZ_ACT;
constexpr size_t WS_END = OFF_R2 + 3 * SZ_ACT;
static_assert(WS_END + 16384 <= 541000000, "workspace");

constexpr size_t OFF_BAR = WS_END;
constexpr int LDS_BYTES = 147712 + 16;

struct Args {
    const float *x, *c, *ctx, *c_ctx, *w_mod, *b_mod, *norm1_g, *w_in, *conv_w, *conv_out, *lam_re, *lam_im, *log_step, *b_re, *b_im, *c_re, *c_im, *s5_d, *glu_a, *glu_b,
        *na_rpb, *na_out, *w_out, *norm2_g, *mlp_w1, *mlp_w2, *final_g;
    float* out; unsigned char* ws; int ph_lo, ph_hi;
};

typedef const Args __attribute__((address_space(4))) KArgs;

__device__ __forceinline__ int tid_() { int t = threadIdx.x; asm volatile("" : "+v"(t)); return t; }
__device__ __forceinline__ int bid_() { int t = blockIdx.x; asm volatile("" : "+s"(t)); return t; }
__device__ __forceinline__ int nblk_() { int t = gridDim.x; asm volatile("" : "+s"(t)); return t; }
__device__ __forceinline__ float bf2f(unsigned b) { return __uint_as_float(b << 16); }
typedef __bf16 bf16v2_t __attribute__((ext_vector_type(2)));
__device__ __forceinline__ unsigned pk2(float lo, float hi) { const f32x2 v = {lo, hi}; return __builtin_bit_cast(unsigned, __builtin_convertvector(v, bf16v2_t)); }
__device__ __forceinline__ float sigmoidf_(float x) { return __builtin_amdgcn_rcpf(1.f + __builtin_amdgcn_exp2f(-1.44269504f * x)); }
__device__ __forceinline__ float gelu_tanh(float x) { const float z = 0.7978845608f * (x + 0.044715f * x * x * x); return x * (1.f - __builtin_amdgcn_rcpf(1.f + __builtin_amdgcn_exp2f(2.88539008f * z))); }
__device__ __forceinline__ void unpack8(const u32x4 v, float (&f)[8]) {
    f[0] = __uint_as_float(v.x << 16); f[1] = __uint_as_float(v.x & 0xffff0000u); f[2] = __uint_as_float(v.y << 16); f[3] = __uint_as_float(v.y & 0xffff0000u);
    f[4] = __uint_as_float(v.z << 16); f[5] = __uint_as_float(v.z & 0xffff0000u); f[6] = __uint_as_float(v.w << 16); f[7] = __uint_as_float(v.w & 0xffff0000u);
}
__device__ __forceinline__ float wave_sum(float v) {
#pragma unroll
    for (int o = 1; o < 64; o <<= 1) v += __shfl_xor(v, o);
    return v;
}
__device__ __forceinline__ float* xrow(KArgs& a, int r) {
    const int b = r / TPB, t = r - b * TPB;
    return t < CTXL ? (float*)(a.ws + OFF_XC) + ((size_t)b * CTXL + t) * DM : a.out + ((size_t)b * SEQ + (t - CTXL)) * DM;
}

#define XB_TMO      128
#define XB_XCNT(j)  (256  + 64 * (j))
#define XB_XSUB(j)  (1280 + 64 * (j))
#define XB_XGEN(j)  (2304 + 64 * (j))
#define XB_TOP      3328
#define XB_TOPGEN   3392
#define XCD_BAR_WORDS 3456
#define XB_SPIN_CAP (1u << 18)

__device__ __forceinline__ unsigned xb_ld(unsigned* p)              { return __hip_atomic_load(p, __ATOMIC_RELAXED, __HIP_MEMORY_SCOPE_AGENT); }
__device__ __forceinline__ unsigned xb_add(unsigned* p, unsigned v) { return __hip_atomic_fetch_add(p, v, __ATOMIC_RELAXED, __HIP_MEMORY_SCOPE_AGENT); }
__device__ __forceinline__ unsigned xb_xcc_id() { return (unsigned)__builtin_amdgcn_s_getreg((3 << 11) | 20) & 0xFu; }
#define XB_SPIN(cond, bar) do { unsigned _sp = 0; while (cond) { __builtin_amdgcn_s_sleep(1); \
    if ((++_sp & 255u) == 0u) { if (xb_ld(&(bar)[XB_TMO])) break; if (_sp > XB_SPIN_CAP) { atomicAdd(&(bar)[XB_TMO], 1u); break; } } } } while (0)

struct XcdBarrier {
    unsigned* bar; unsigned x;
    volatile LAS unsigned* st;
};

__device__ __forceinline__ XcdBarrier xcd_barrier_post(unsigned* bar, volatile LAS unsigned* st) {
    XcdBarrier b; b.bar = bar; b.x = xb_xcc_id(); b.st = st;
    if (threadIdx.x == 0) (void)xb_add(&bar[XB_XCNT(b.x)], 1u);
    return b;
}
__device__ __forceinline__ void xcd_barrier_complete(unsigned* bar, unsigned x, unsigned& nloc, unsigned& nx) {
    const unsigned G = gridDim.x * gridDim.y * gridDim.z;
    unsigned sum, cnt, mine, sp = 0u;
    for (;;) {
        sum = 0u; cnt = 0u; mine = 0u;
#pragma unroll
        for (unsigned j = 0; j < 16; ++j) { const unsigned c = xb_ld(&bar[XB_XCNT(j)]); sum += c; cnt += (c > 0u) ? 1u : 0u; mine = (j == x) ? c : mine; }
        if (sum == G) break;
        __builtin_amdgcn_s_sleep(1);
        if ((++sp & 255u) == 0u) { if (xb_ld(&bar[XB_TMO])) break; if (sp > XB_SPIN_CAP) { atomicAdd(&bar[XB_TMO], 1u); break; } }
    }
    nloc = mine > 0u ? mine : 1u; nx = cnt > 0u ? cnt : 1u;
}

__device__ __forceinline__ void xcd_barrier(const XcdBarrier& b) {
    asm volatile("s_waitcnt vmcnt(0)" ::: "memory");
    __syncthreads();
    if (threadIdx.x == 0) {
        unsigned* bar = b.bar;
        __builtin_amdgcn_s_waitcnt(0);
        unsigned nloc = b.st[0], nx = b.st[1];
        if (nloc == 0u) { xcd_barrier_complete(bar, b.x, nloc, nx); b.st[0] = nloc; b.st[1] = nx; }
        const unsigned old = xb_add(&bar[XB_XSUB(b.x)], 1u);
        const unsigned gen = old / nloc;
        if (old + 1u == (gen + 1u) * nloc) {
            __builtin_amdgcn_fence(__ATOMIC_RELEASE, "agent");
            asm volatile("s_waitcnt vmcnt(0)" ::: "memory");
            const unsigned og = xb_add(&bar[XB_TOP], 1u);
            const unsigned tg = og / nx;
            if (og + 1u == (tg + 1u) * nx) xb_add(&bar[XB_TOPGEN], 1u);
            else XB_SPIN(xb_ld(&bar[XB_TOPGEN]) == tg, bar);
            __builtin_amdgcn_fence(__ATOMIC_ACQUIRE, "agent");
            xb_add(&bar[XB_XGEN(b.x)], 1u);
            asm volatile("s_waitcnt vmcnt(0)" ::: "memory");
        } else {
            XB_SPIN(xb_ld(&bar[XB_XGEN(b.x)]) == gen, bar);
            __builtin_amdgcn_fence(__ATOMIC_ACQUIRE, "agent");
            asm volatile("s_waitcnt vmcnt(0)" ::: "memory");
        }
    }
    __syncthreads();
}


namespace pg8 {
constexpr int BM = 256, BK = 64, HALF = 128, HTB = HALF * BK * 2, STAGE_BYTES = 8 * HTB, NXCD = 8, WGM = 8;
__device__ __forceinline__ int lds_byte(int r, int c) { const int st = (r >> 4) * 2 + (c >> 5), rr = r & 15, cc = c & 31, ob = rr * 64 + cc * 2; return st * 1024 + (ob ^ (((ob >> 9) & 1) << 5)); }
__device__ __forceinline__ int perm32(int rho) { const int n = rho >> 4, i = rho & 15; return 8 * (i >> 2) + 4 * n + (i & 3); }
__device__ __forceinline__ void stage_rc(int b, int& R, int& C) { const int st = b / 1024, sb = b % 1024, swz = sb ^ (((sb >> 9) & 1) << 5); R = (st >> 1) * 16 + swz / 64; C = (st & 1) * 32 + (swz % 64) / 2; }

struct Unit { int batch, pm, pn, aux; };
__device__ __forceinline__ void std_map(int wgid, int nM, int nN, int& pm, int& pn) {
    const int nwg = nM * nN;
    { const int q = nwg / NXCD, r = nwg % NXCD, xcd = wgid % NXCD, off = wgid / NXCD; wgid = (xcd < r ? xcd * (q + 1) : r * (q + 1) + (xcd - r) * q) + off; }
    const int nig = WGM * nN, gid = wgid / nig, fm = gid * WGM, gsz = (nM - fm) < WGM ? (nM - fm) : WGM;
    pm = fm + ((wgid % nig) % gsz); pn = (wgid % nig) / gsz;
}
struct StdProb {
    size_t ksA = 128, ksB = 128;
    const bf16_t* A; const bf16_t* Bt; int lda, ldb, K; size_t strideA, strideB; int nM, nN, nwg, total, G, c;
    __device__ __forceinline__ StdProb(const bf16_t* A_, const bf16_t* Bt_, int lda_, int ldb_, int K_, size_t sA, size_t sB, int nM_, int nN_, int nbatch, int G_, int c_)
        : A(A_), Bt(Bt_), lda(lda_), ldb(ldb_), K(K_), strideA(sA), strideB(sB), nM(nM_), nN(nN_), nwg(nM_ * nN_), total(nM_ * nN_ * nbatch), G(G_), c(c_) {}
    bool skipctx = false;
    __device__ __forceinline__ bool next(int i, Unit& u) const {
        const int L = i * G + c; if (L >= total) return false;
        u.batch = L / nwg; std_map(L - u.batch * nwg, nM, nN, u.pm, u.pn); if (skipctx) u.pm += (u.pm >> 4) + 1; return true;
    }
    __device__ __forceinline__ int ktiles(const Unit&) const { return K / BK; }
    __device__ __forceinline__ size_t kstepA() const { return ksA; }
    __device__ __forceinline__ size_t kstepB() const { return ksB; }
    __device__ __forceinline__ bool full(const Unit&) const { return true; }
    __device__ __forceinline__ long bhalf(const Unit&) const { return (long)HALF * ldb * 2; }
    __device__ __forceinline__ const char* abase(const Unit& u) const { return (const char*)(A + (size_t)u.batch * strideA + (size_t)u.pm * 256 * lda); }
    __device__ __forceinline__ const char* bbase(const Unit& u) const { return (const char*)(Bt + (size_t)u.batch * strideB + (size_t)u.pn * 256 * ldb); }
};
struct In1Prob {
    const bf16_t* HN; const bf16_t* W; int lda, ldb, K, G, c;
    __device__ __forceinline__ bool next(int i, Unit& u) const {
        const int L = i * G + c; if (L >= 1632 + 272) return false;
        if (L < 1632) { u.batch = 0; std_map(L, 136, 12, u.pm, u.pn); } else { const int j = L - 1632; u.batch = 1; u.pm = j & 1; u.pn = j >> 1; }
        return true;
    }
    __device__ __forceinline__ int ktiles(const Unit&) const { return K / BK; }
    __device__ __forceinline__ size_t kstepA() const { return 128; }
    __device__ __forceinline__ size_t kstepB() const { return 128; }
    __device__ __forceinline__ bool full(const Unit&) const { return true; }
    __device__ __forceinline__ long bhalf(const Unit&) const { return (long)HALF * ldb * 2; }
    __device__ __forceinline__ const char* abase(const Unit& u) const { return (const char*)(u.batch == 0 ? HN + (size_t)u.pm * 256 * DM : W + (size_t)(3072 + u.pm * 256) * DM); }
    __device__ __forceinline__ const char* bbase(const Unit& u) const { return (const char*)(u.batch == 0 ? W + (size_t)u.pn * 256 * DM : HN + (size_t)u.pn * 256 * DM); }
};
struct MergeProb {
    const bf16_t* GS5; const bf16_t* ACV; const bf16_t* OAT; const bf16_t* WA; int lda, ldb, K, G, c, nM;
    __device__ __forceinline__ bool next(int i, Unit& u) const {
        const int U = (i >> 2) * G + c; if (U >= nM * 4) return false;
        u.batch = i & 3; std_map(U, nM, 4, u.pm, u.pn); if (nM == 128) u.pm += (u.pm >> 4) + 1; return true;
    }
    __device__ __forceinline__ int ktiles(const Unit&) const { return 8; }
    __device__ __forceinline__ size_t kstepA() const { return 128; }
    __device__ __forceinline__ size_t kstepB() const { return 128; }
    __device__ __forceinline__ bool full(const Unit&) const { return true; }
    __device__ __forceinline__ long bhalf(const Unit&) const { return (long)HALF * ldb * 2; }
    __device__ __forceinline__ const char* abase(const Unit& u) const { const int sl = (u.batch & 2) ? ((u.batch & 1) << 1) : 1; return (const char*)(ACV + (size_t)sl * (SZ_ACT / 2) + (size_t)u.pm * 256 * 512); }
    __device__ __forceinline__ const char* bbase(const Unit& u) const { const int t = (u.batch + 1) >> 2, sl = t * 3 + (1 - t) * (2 - u.batch); return (const char*)(WA + WA_CONV / 2 + (size_t)sl * 524288 + (size_t)u.pn * 256 * 512); }
};
struct CPProb {
    const bf16_t* ACV; const bf16_t* WA; int lda, ldb, K, G, c, nM;
    __device__ __forceinline__ bool next(int i, Unit& u) const {
        const int su = i / 3, U = su * G + c; if (U >= nM * 8) return false;
        u.batch = i - 3 * su; u.aux = 0; std_map(U, nM, 8, u.pm, u.pn); if (nM == 128) u.pm += (u.pm >> 4) + 1; return true;
    }
    __device__ __forceinline__ int ktiles(const Unit&) const { return 8; }
    __device__ __forceinline__ size_t kstepA() const { return 128; }
    __device__ __forceinline__ size_t kstepB() const { return 128; }
    __device__ __forceinline__ bool full(const Unit& u) const { return u.batch == 0; }
    __device__ __forceinline__ long bhalf(const Unit& u) const { return u.batch == 0 ? (long)WA_GLUA - (long)WA_GLUB : 0L; }
    __device__ __forceinline__ const char* abase(const Unit& u) const { const int sl = 1 - u.batch + 3 * (u.batch >> 1); return (const char*)(ACV + (size_t)sl * (SZ_ACT / 2) + (size_t)u.pm * 256 * 512); }
    __device__ __forceinline__ const char* bbase(const Unit& u) const { const int sl = 2 * (u.batch == 0 ? 1 : 0) + 3 * (u.batch >> 1); return (const char*)(WA + WA_CONV / 2 + (size_t)sl * 524288 + (size_t)u.pn * 128 * 512); }
};
struct HalfMergeProb {
    const bf16_t* ACV; const bf16_t* WA; int lda, ldb, K, G, c, nM2;
    __device__ __forceinline__ bool next(int i, Unit& u) const {
        const int U = (i >> 2) * G + c; if (U >= nM2 * 4) return false;
        u.batch = i & 3; u.aux = 0; std_map(U, nM2, 4, u.pm, u.pn); if (nM2 == 256) u.pm += 2 * (u.pm >> 5) + 2; return true;
    }
    __device__ __forceinline__ int ktiles(const Unit&) const { return 8; }
    __device__ __forceinline__ size_t kstepA() const { return 128; }
    __device__ __forceinline__ size_t kstepB() const { return 128; }
    __device__ __forceinline__ bool full(const Unit&) const { return true; }
    __device__ __forceinline__ long bhalf(const Unit&) const { return (long)HALF * ldb * 2; }
    __device__ __forceinline__ const char* abase(const Unit& u) const { const int sl = (u.batch & 2) ? ((u.batch & 1) << 1) : 1; return (const char*)(ACV + (size_t)sl * (SZ_ACT / 2) + (size_t)u.pm * 128 * 512); }
    __device__ __forceinline__ const char* bbase(const Unit& u) const { const int t = (u.batch + 1) >> 2, sl = t * 3 + (1 - t) * (2 - u.batch); return (const char*)(WA + WA_CONV / 2 + (size_t)sl * 524288 + (size_t)u.pn * 256 * 512); }
};
template <int NS> struct TailProb {
    size_t ksA = 128, ksB = 128; size_t sliceA = 0, sliceB = 0;
    const bf16_t* A; const bf16_t* Bt; int lda, ldb, K, G, c, nunits, nfull;
    __device__ __forceinline__ TailProb(const bf16_t* A_, const bf16_t* Bt_, int ld, int K_, int G_, int c_, bool split) : A(A_), Bt(Bt_), lda(ld), ldb(ld), K(K_), G(G_), c(c_) { nunits = 544; nfull = split ? 512 : 544; }
    __device__ __forceinline__ bool next(int i, Unit& u) const {
        const int L = i * G + c; const int ntail = nunits - nfull;
        if (L < nfull) { u.batch = 0; u.aux = 0; std_map(L, 136, 4, u.pm, u.pn); return true; }
        const int j = L - nfull; if (j >= ntail * NS) return false;
        u.batch = 1 + j / ntail; u.aux = j % ntail; std_map(nfull + u.aux, 136, 4, u.pm, u.pn); return true;
    }
    __device__ __forceinline__ int ktiles(const Unit& u) const { return u.batch == 0 ? K / BK : K / (BK * NS); }
    __device__ __forceinline__ size_t kstepA() const { return ksA; }
    __device__ __forceinline__ size_t kstepB() const { return ksB; }
    __device__ __forceinline__ bool full(const Unit&) const { return true; }
    __device__ __forceinline__ long bhalf(const Unit&) const { return (long)HALF * ldb * 2; }
    __device__ __forceinline__ const char* abase(const Unit& u) const { return (const char*)(A + (size_t)u.pm * 256 * lda + (u.batch == 0 ? (size_t)0 : (size_t)(u.batch - 1) * (sliceA ? sliceA : (size_t)(K / NS)))); }
    __device__ __forceinline__ const char* bbase(const Unit& u) const { return (const char*)(Bt + (size_t)u.pn * 256 * ldb + (u.batch == 0 ? (size_t)0 : (size_t)(u.batch - 1) * (sliceB ? sliceB : (size_t)(K / NS)))); }
};
template <class F> __device__ __forceinline__ void epi_foreach(const f32x4 (&acc)[2][2][4][2], int wr, int wc, int fr, int fq, F f) {
#pragma unroll
    for (int ai = 0; ai < 2; ++ai)
#pragma unroll
        for (int m = 0; m < 4; ++m)
#pragma unroll
            for (int bj = 0; bj < 2; ++bj)
#pragma unroll
                for (int n = 0; n < 2; ++n) f(ai * HALF + wr * 64 + m * 16 + fr, bj * HALF + wc * 32 + n * 16 + 4 * fq, acc[ai][bj][m][n]);
}

template <class F> __device__ __forceinline__ void epi_foreach8(const f32x4 (&acc)[2][2][4][2], int wr, int wc, int fr, int fq, F f) {
#pragma unroll
    for (int ai = 0; ai < 2; ++ai)
#pragma unroll
        for (int m = 0; m < 4; ++m)
#pragma unroll
            for (int bj = 0; bj < 2; ++bj) f(ai * HALF + wr * 64 + m * 16 + fr, bj * HALF + wc * 32 + 8 * fq, acc[ai][bj][m][0], acc[ai][bj][m][1]);
}
template <bool HM = false, bool PERM = false, bool CP = false, class Prob, class Epi>
__device__ __forceinline__ void gemm_phase(LAS unsigned char* lds, const Prob& S, const Epi& E) {
    int tid = threadIdx.x; asm volatile("" : "+v"(tid));
    const int wid = __builtin_amdgcn_readfirstlane(tid >> 6), lane = tid & 63, wr = wid >> 2, wc = wid & 3, fr = lane & 15, fq = lane >> 4;
    unsigned voffA[2], voffB[2];
#pragma unroll
    for (int i = 0; i < 2; ++i) { int R, C; stage_rc(tid * 16 + i * 8192, R, C); const int Rb = PERM ? ((R & ~31) + perm32(R & 31)) : R; voffA[i] = (unsigned)(R * S.lda + C) * 2u; voffB[i] = (unsigned)(Rb * S.ldb + C) * 2u; }
    const size_t kstepA = S.kstepA(), kstepB = S.kstepB();
    const size_t hstepA = HM ? 0 : (size_t)HALF * S.lda * 2; const long hstepB0 = (long)HALF * S.ldb * 2;
    const unsigned ldsw = (unsigned)wid * 1024u;
    const int aoff = lds_byte(wr * 64 + fr, fq * 8), boff = lds_byte(wc * 32 + fr, fq * 8);
#define PG8_SA(b, h) (((b) * 2 + (h)) * HTB)
#define PG8_SB(b, h) ((4 + (b) * 2 + (h)) * HTB)
#define PG8_STAGE(bufoff, gbase, voff) do { _Pragma("unroll") for (int _i = 0; _i < 2; ++_i) \
        __builtin_amdgcn_global_load_lds((const unsigned*)((const char*)(gbase) + (voff)[_i]), (LAS unsigned*)(lds + (bufoff) + ldsw + _i * 8192), 16, 0, 0); } while (0)
#define PG8_LDA(dst, b, h) do { _Pragma("unroll") for (int m = 0; m < 4; ++m) _Pragma("unroll") for (int k = 0; k < 2; ++k) dst[m][k] = *(const LAS bf16x8*)(lds + PG8_SA(b, h) + aoff + m * 2048 + k * 1024); } while (0)
#define PG8_LDB(dst, b, h) do { _Pragma("unroll") for (int n = 0; n < 2; ++n) _Pragma("unroll") for (int k = 0; k < 2; ++k) dst[n][k] = *(const LAS bf16x8*)(lds + PG8_SB(b, h) + boff + n * 2048 + k * 1024); } while (0)
#define PG8_MMA(ai, bj, At, Bt) do { __builtin_amdgcn_s_setprio(1); _Pragma("unroll") for (int m = 0; m < 4; ++m) _Pragma("unroll") for (int n = 0; n < 2; ++n) _Pragma("unroll") for (int k = 0; k < 2; ++k) \
        acc[ai][bj][m][n] = __builtin_amdgcn_mfma_f32_16x16x32_bf16(Bt[n][k], At[m][k], acc[ai][bj][m][n], 0, 0, 0); __builtin_amdgcn_s_setprio(0); } while (0)
#define PG8_WAIT_V(n) asm volatile("s_waitcnt vmcnt(" #n ")" ::: "memory")
#define PG8_WAIT_L(n) asm volatile("s_waitcnt lgkmcnt(" #n ")" ::: "memory")
#define PG8_BAR __builtin_amdgcn_s_barrier()
#define PG8_SCHED __builtin_amdgcn_sched_barrier(0)
    Unit cur, nxt; int ui = 0;
    if (!S.next(0, cur)) return;
    f32x4 acc[2][2][4][2];
#pragma unroll
    for (int a = 0; a < 2; ++a)
#pragma unroll
        for (int b = 0; b < 2; ++b)
#pragma unroll
            for (int m = 0; m < 4; ++m)
#pragma unroll
                for (int n = 0; n < 2; ++n) acc[a][b][m][n] = (f32x4){0.f, 0.f, 0.f, 0.f};
    bf16x8 At[4][2], B0[2][2], B1[2][2];
    const char* cA = S.abase(cur);
    const char* cB = S.bbase(cur);
    long chB = CP ? S.bhalf(cur) : hstepB0; bool fullu = CP ? S.full(cur) : true;
#if GEMM_SP2
    PG8_STAGE(PG8_SB(0, 0), cB, voffB); PG8_STAGE(PG8_SB(0, 1), cB + chB, voffB); PG8_STAGE(PG8_SA(0, 0), cA, voffA); PG8_STAGE(PG8_SA(0, 1), cA + hstepA, voffA);
    if (wr == 1) PG8_BAR;
    PG8_WAIT_V(2); PG8_BAR;
    PG8_STAGE(PG8_SB(1, 0), cB + kstepB, voffB); PG8_STAGE(PG8_SA(1, 0), cA + kstepA, voffA); PG8_STAGE(PG8_SB(1, 1), cB + chB + kstepB, voffB);
    PG8_WAIT_V(6); PG8_BAR;
#else
    PG8_STAGE(PG8_SB(0, 0), cB, voffB); PG8_STAGE(PG8_SA(0, 0), cA, voffA); PG8_STAGE(PG8_SB(0, 1), cB + chB, voffB); PG8_STAGE(PG8_SA(0, 1), cA + hstepA, voffA);
    if (wr == 1) PG8_BAR;
    PG8_WAIT_V(4); PG8_BAR;
    PG8_STAGE(PG8_SB(1, 0), cB + kstepB, voffB); PG8_STAGE(PG8_SA(1, 0), cA + kstepA, voffA); PG8_STAGE(PG8_SB(1, 1), cB + chB + kstepB, voffB);
    PG8_WAIT_V(6); PG8_BAR;
#endif
    for (;;) {
        const bool has_next = S.next(ui + 1, nxt);
        const char* nA = has_next ? S.abase(nxt) : cA;
        const char* nB = has_next ? S.bbase(nxt) : cB;
        const long nhB = (CP && has_next) ? S.bhalf(nxt) : chB;
        const int nt = S.ktiles(cur);
        for (int t = 0; t < nt; t += 2) {
            const bool last = (t == nt - 2);
            const char* a1 = cA + (size_t)(t + 1) * kstepA;
            const char* a2 = last ? nA : cA + (size_t)(t + 2) * kstepA; const char* b2 = last ? nB : cB + (size_t)(t + 2) * kstepB;
            const char* a3 = a2 + kstepA; const char* b3 = b2 + kstepB; const long h2 = last ? nhB : chB;
#if GEMM_SP2
            PG8_LDB(B0, 0, 0); PG8_LDB(B1, 0, 1); PG8_SCHED; PG8_LDA(At, 0, 0); PG8_STAGE(PG8_SA(1, 1), a1 + hstepA, voffA);
            PG8_WAIT_V(8); PG8_WAIT_L(0); PG8_BAR; if (!CP || fullu) PG8_MMA(0, 0, At, B0); PG8_MMA(0, 1, At, B1); PG8_BAR; PG8_SCHED;
            if (!HM) PG8_LDA(At, 0, 1); PG8_STAGE(PG8_SB(0, 0), b2, voffB); PG8_STAGE(PG8_SB(0, 1), b2 + h2, voffB); PG8_STAGE(PG8_SA(0, 0), a2, voffA);
            PG8_WAIT_V(8); PG8_WAIT_L(0); PG8_BAR; if (!HM) { if (!CP || fullu) PG8_MMA(1, 0, At, B0); PG8_MMA(1, 1, At, B1); } PG8_BAR; PG8_SCHED;
            PG8_LDB(B0, 1, 0); PG8_LDB(B1, 1, 1); PG8_SCHED; PG8_LDA(At, 1, 0); PG8_STAGE(PG8_SA(0, 1), a2 + hstepA, voffA);
            PG8_WAIT_V(8); PG8_WAIT_L(0); PG8_BAR; if (!CP || fullu) PG8_MMA(0, 0, At, B0); PG8_MMA(0, 1, At, B1); PG8_BAR; PG8_SCHED;
            if (!HM) PG8_LDA(At, 1, 1); PG8_STAGE(PG8_SB(1, 0), b3, voffB); PG8_STAGE(PG8_SB(1, 1), b3 + h2, voffB); PG8_STAGE(PG8_SA(1, 0), a3, voffA);
            PG8_WAIT_V(8); PG8_WAIT_L(0); PG8_BAR; if (!HM) { if (!CP || fullu) PG8_MMA(1, 0, At, B0); PG8_MMA(1, 1, At, B1); } PG8_BAR; PG8_SCHED;
#else
            PG8_LDB(B0, 0, 0); PG8_SCHED; PG8_LDA(At, 0, 0); PG8_STAGE(PG8_SA(1, 1), a1 + hstepA, voffA);
            PG8_WAIT_L(8); PG8_BAR; PG8_WAIT_L(0); PG8_MMA(0, 0, At, B0); PG8_BAR; PG8_SCHED;
            PG8_LDB(B1, 0, 1); PG8_STAGE(PG8_SB(0, 0), b2, voffB);
            PG8_BAR; PG8_WAIT_L(0); PG8_MMA(0, 1, At, B1); PG8_BAR;
            if (!HM) PG8_LDA(At, 0, 1); PG8_STAGE(PG8_SA(0, 0), a2, voffA);
            PG8_BAR; PG8_WAIT_L(0); if (!HM) PG8_MMA(1, 0, At, B0); PG8_BAR; PG8_SCHED;
            PG8_STAGE(PG8_SB(0, 1), b2 + h2, voffB);
            PG8_WAIT_V(6); PG8_BAR; if (!HM) PG8_MMA(1, 1, At, B1); PG8_BAR;
            PG8_LDB(B0, 1, 0); PG8_SCHED; PG8_LDA(At, 1, 0); PG8_STAGE(PG8_SA(0, 1), a2 + hstepA, voffA);
            PG8_WAIT_L(8); PG8_BAR; PG8_WAIT_L(0); PG8_MMA(0, 0, At, B0); PG8_BAR; PG8_SCHED;
            PG8_LDB(B1, 1, 1); PG8_STAGE(PG8_SB(1, 0), b3, voffB);
            PG8_BAR; PG8_WAIT_L(0); PG8_MMA(0, 1, At, B1); PG8_BAR;
            if (!HM) PG8_LDA(At, 1, 1); PG8_STAGE(PG8_SA(1, 0), a3, voffA);
            PG8_BAR; PG8_WAIT_L(0); if (!HM) PG8_MMA(1, 0, At, B0); PG8_BAR; PG8_SCHED;
            PG8_STAGE(PG8_SB(1, 1), b3 + h2, voffB);
            PG8_WAIT_V(6); PG8_BAR; if (!HM) PG8_MMA(1, 1, At, B1); PG8_BAR;
#endif
        }
        if (wr == 0) PG8_BAR;
        { int fr2 = fr, fq2 = fq; asm volatile("" : "+v"(fr2), "+v"(fq2)); E(acc, cur, wr, wc, fr2, fq2); }
        if (!has_next) break;
        if (CP) {
            const bool nf = S.full(nxt);
#pragma unroll
            for (int a = 0; a < 2; ++a)
#pragma unroll
                for (int m = 0; m < 4; ++m)
#pragma unroll
                    for (int n = 0; n < 2; ++n) { acc[a][1][m][n] = (f32x4){0.f, 0.f, 0.f, 0.f}; if (nf) acc[a][0][m][n] = (f32x4){0.f, 0.f, 0.f, 0.f}; }
            fullu = nf; chB = nhB;
        } else {
#pragma unroll
        for (int a = 0; a < (HM ? 1 : 2); ++a)
#pragma unroll
            for (int b = 0; b < 2; ++b)
#pragma unroll
                for (int m = 0; m < 4; ++m)
#pragma unroll
                    for (int n = 0; n < 2; ++n) acc[a][b][m][n] = (f32x4){0.f, 0.f, 0.f, 0.f};
        }
        cur = nxt; cA = nA; cB = nB; ++ui;
        if (wr == 1) PG8_BAR;
    }
    PG8_WAIT_V(0);
    PG8_BAR;
#undef PG8_SA
#undef PG8_SB
#undef PG8_STAGE
#undef PG8_LDA
#undef PG8_LDB
#undef PG8_MMA
#undef PG8_WAIT_V
#undef PG8_WAIT_L
#undef PG8_BAR
#undef PG8_SCHED
}
}
using pg8::Unit;

struct TileRows { int b, tb; __device__ __forceinline__ TileRows(int pm) { b = pm / 17; tb = pm - 17 * b; } };

struct EpiIn1 {
    bf16_t* PA; bf16_t* A2; bf16_t* VT;
    __device__ __forceinline__ void operator()(const f32x4 (&acc)[2][2][4][2], const Unit& u, int wr, int wc, int fr, int fq) const {
        const int row0 = u.pm * 256, col0 = u.pn * 256;
        if (u.batch == 1) {
            const int b = u.pn / 17, t0 = (u.pn - 17 * b) * 256;
            pg8::epi_foreach(acc, wr, wc, fr, fq, [&](int rl, int cl, const f32x4& v) {
                u32x2 o; o.x = pk2(v[0], v[1]); o.y = pk2(v[2], v[3]);
                *(u32x2*)(VT + ((size_t)b * 512 + row0 + rl) * TPB + t0 + cl) = o; });
        } else if (u.pn == 6 || u.pn == 7) {
            const TileRows tr(u.pm);
            pg8::epi_foreach(acc, wr, wc, fr, fq, [&](int rl, int cl, const f32x4& v) {
                const int t = tr.tb * 256 + rl, cr = tr.b * CPB + (t >> 5), s = t & 31, j = col0 - 1536 + cl, gidx = j >> 4, mm = j & 15;
                u32x2 o; o.x = pk2(v[0], v[1]); o.y = pk2(v[2], v[3]);
                *(u32x2*)(A2 + ((size_t)gidx * NCR + cr) * 768 + s * 16 + mm) = o; });
        } else {
            const int cdst = col0 - (u.pn >= 8 ? 512 : 0);
            pg8::epi_foreach(acc, wr, wc, fr, fq, [&](int rl, int cl, const f32x4& v) {
                u32x2 o; o.x = pk2(v[0], v[1]); o.y = pk2(v[2], v[3]);
                *(u32x2*)(PA + (size_t)(row0 + rl) * PALD + cdst + cl) = o; });
        }
    }
};
struct EpiIn1P {
    bf16_t* PA; bf16_t* A2; bf16_t* VT; bf16_t* KH;
    __device__ __forceinline__ void operator()(const f32x4 (&acc)[2][2][4][2], const Unit& u, int wr, int wc, int fr, int fq) const {
        const int row0 = u.pm * 256, col0 = u.pn * 256;
        if (u.batch == 1) {
            const int b = u.pn / 17, t0 = (u.pn - 17 * b) * 256;
            pg8::epi_foreach8(acc, wr, wc, fr, fq, [&](int rl, int cl, const f32x4& v0, const f32x4& v1) {
                const int f = row0 + rl, hh = f >> 6, dim = f & 63, t = t0 + cl;
                u32x4 o; o.x = pk2(v0[0], v0[1]); o.y = pk2(v0[2], v0[3]); o.z = pk2(v1[0], v1[1]); o.w = pk2(v1[2], v1[3]); *(u32x4*)(VT + (((size_t)(b * 8 + hh) * 544 + (t >> 3)) * 64 + dim) * 8) = o; });
        } else if (u.pn == 6 || u.pn == 7) {
            const TileRows tr(u.pm);
            pg8::epi_foreach8(acc, wr, wc, fr, fq, [&](int rl, int cl, const f32x4& v0, const f32x4& v1) {
                const int t = tr.tb * 256 + rl, cr = tr.b * CPB + (t >> 5), s = t & 31, j = col0 - 1536 + cl, gidx = j >> 4, mm = j & 15;
                u32x4 o; o.x = pk2(v0[0], v0[1]); o.y = pk2(v0[2], v0[3]); o.z = pk2(v1[0], v1[1]); o.w = pk2(v1[2], v1[3]); *(u32x4*)(A2 + ((size_t)gidx * NCR + cr) * 768 + s * 16 + mm) = o; });
        } else if (u.pn >= 10) {
            const TileRows tr(u.pm);
            pg8::epi_foreach8(acc, wr, wc, fr, fq, [&](int rl, int cl, const f32x4& v0, const f32x4& v1) {
                const int kc = col0 - 2560 + cl, hh = kc >> 6, dim = kc & 63, t = tr.tb * 256 + rl;
                u32x4 o; o.x = pk2(v0[0], v0[1]); o.y = pk2(v0[2], v0[3]); o.z = pk2(v1[0], v1[1]); o.w = pk2(v1[2], v1[3]); *(u32x4*)(KH + ((size_t)(tr.b * 8 + hh) * TPB + t) * 64 + dim) = o; });
        } else {
            const int cdst = col0 - (u.pn >= 8 ? 512 : 0);
            pg8::epi_foreach8(acc, wr, wc, fr, fq, [&](int rl, int cl, const f32x4& v0, const f32x4& v1) {
                u32x4 o; o.x = pk2(v0[0], v0[1]); o.y = pk2(v0[2], v0[3]); o.z = pk2(v1[0], v1[1]); o.w = pk2(v1[2], v1[3]); *(u32x4*)(PA + (size_t)(row0 + rl) * PALD + cdst + cl) = o; });
        }
    }
};
struct EpiYP {
    bf16_t* G;
    __device__ __forceinline__ void operator()(const f32x4 (&acc)[2][2][4][2], const Unit& u, int wr, int wc, int fr, int fq) const {
        pg8::epi_foreach8(acc, wr, wc, fr, fq, [&](int rl, int cl, const f32x4& a0, const f32x4& a1) {
            const int cr = u.pm * 256 + rl; if (cr < NCR) { const int b = cr / CPB, ch = cr - b * CPB, col = u.pn * 256 + cl, t = col >> 4, n = col & 15;
                const f32x4 v0 = {gelu_tanh(a0[0]), gelu_tanh(a0[1]), gelu_tanh(a0[2]), gelu_tanh(a0[3])}, v1 = {gelu_tanh(a1[0]), gelu_tanh(a1[1]), gelu_tanh(a1[2]), gelu_tanh(a1[3])};
                u32x4 o; o.x = pk2(v0[0], v0[1]); o.y = pk2(v0[2], v0[3]); o.z = pk2(v1[0], v1[1]); o.w = pk2(v1[2], v1[3]); *(u32x4*)(G + ((size_t)b * TPB + ch * TCH + t) * 512 + u.batch * 16 + n) = o; } });
    }
};
struct EpiGatesP {
    bf16_t* GT;
    __device__ __forceinline__ void operator()(const f32x4 (&acc)[2][2][4][2], const Unit& u, int wr, int wc, int fr, int fq) const {
        pg8::epi_foreach8(acc, wr, wc, fr, fq, [&](int rl, int cl, const f32x4& a0, const f32x4& a1) {
            const f32x4 v0 = {sigmoidf_(a0[0]), sigmoidf_(a0[1]), sigmoidf_(a0[2]), sigmoidf_(a0[3])}, v1 = {sigmoidf_(a1[0]), sigmoidf_(a1[1]), sigmoidf_(a1[2]), sigmoidf_(a1[3])};
            u32x4 o; o.x = pk2(v0[0], v0[1]); o.y = pk2(v0[2], v0[3]); o.z = pk2(v1[0], v1[1]); o.w = pk2(v1[2], v1[3]); __builtin_nontemporal_store(o, (u32x4*)(GT + (size_t)(u.pm * 256 + rl) * 3072 + u.pn * 256 + cl)); });
    }
};
struct EpiSqReluP {
    bf16_t* Hd;
    __device__ __forceinline__ void operator()(const f32x4 (&acc)[2][2][4][2], const Unit& u, int wr, int wc, int fr, int fq) const {
        pg8::epi_foreach8(acc, wr, wc, fr, fq, [&](int rl, int cl, const f32x4& a0, const f32x4& a1) {
            f32x4 v0, v1;
#pragma unroll
            for (int i = 0; i < 4; ++i) { const float r0 = fmaxf(a0[i], 0.f), r1 = fmaxf(a1[i], 0.f); v0[i] = r0 * r0; v1[i] = r1 * r1; }
            u32x4 o; o.x = pk2(v0[0], v0[1]); o.y = pk2(v0[2], v0[3]); o.z = pk2(v1[0], v1[1]); o.w = pk2(v1[2], v1[3]); const int cc = u.pn * 256 + cl; __builtin_nontemporal_store(o, (u32x4*)(Hd + ((size_t)(cc >> 6) * MTOK + (size_t)(u.pm * 256 + rl)) * 64 + (cc & 63))); });
    }
};
struct EpiE {
    float* E;
    __device__ __forceinline__ void operator()(const f32x4 (&acc)[2][2][4][2], const Unit& u, int wr, int wc, int fr, int fq) const {
        pg8::epi_foreach(acc, wr, wc, fr, fq, [&](int rl, int cl, const f32x4& v) {
            const int r = u.pm * 256 + rl; if (r < NCR) *(f32x4*)(E + ((size_t)u.batch * NCR + r) * 256 + cl) = v; });
    }
};
struct EpiY {
    bf16_t* G;
    __device__ __forceinline__ void operator()(const f32x4 (&acc)[2][2][4][2], const Unit& u, int wr, int wc, int fr, int fq) const {
        pg8::epi_foreach(acc, wr, wc, fr, fq, [&](int rl, int cl, const f32x4& v) {
            const int cr = u.pm * 256 + rl; if (cr < NCR) { const int b = cr / CPB, ch = cr - b * CPB, col = u.pn * 256 + cl, t = col >> 4, n = col & 15;
                u32x2 o; o.x = pk2(gelu_tanh(v[0]), gelu_tanh(v[1])); o.y = pk2(gelu_tanh(v[2]), gelu_tanh(v[3]));
                *(u32x2*)(G + ((size_t)b * TPB + ch * TCH + t) * 512 + u.batch * 16 + n) = o; } });
    }
};
struct EpiGates {
    bf16_t* GT;
    __device__ __forceinline__ void operator()(const f32x4 (&acc)[2][2][4][2], const Unit& u, int wr, int wc, int fr, int fq) const {
        pg8::epi_foreach(acc, wr, wc, fr, fq, [&](int rl, int cl, const f32x4& v) {
            u32x2 o; o.x = pk2(sigmoidf_(v[0]), sigmoidf_(v[1])); o.y = pk2(sigmoidf_(v[2]), sigmoidf_(v[3]));
            *(u32x2*)(GT + (size_t)(u.pm * 256 + rl) * 3072 + u.pn * 256 + cl) = o; });
    }
};
template <int MODE> struct EpiMerge {
    bf16_t* Mg; const bf16_t* GT;
    __device__ __forceinline__ void operator()(const f32x4 (&acc)[2][2][4][2], const Unit& u, int wr, int wc, int fr, int fq) const {
        pg8::epi_foreach(acc, wr, wc, fr, fq, [&](int rl, int cl, const f32x4& v) {
            const size_t r = (size_t)(u.pm * 256 + rl); const int c = u.pn * 256 + cl;
            u32x2* mp = (u32x2*)(Mg + r * DM + c);
            float gv[4] = {1.f, 1.f, 1.f, 1.f}, mv[4] = {0.f, 0.f, 0.f, 0.f};
            if (MODE != 1) { const u32x2 gq = *(const u32x2*)(GT + r * 3072 + (MODE == 0 ? 1024 : (MODE == 2 ? 0 : 2048)) + c);
                gv[0] = bf2f(gq.x & 0xffffu); gv[1] = __uint_as_float(gq.x & 0xffff0000u); gv[2] = bf2f(gq.y & 0xffffu); gv[3] = __uint_as_float(gq.y & 0xffff0000u); }
            if (MODE != 0) { const u32x2 mq = *mp;
                mv[0] = bf2f(mq.x & 0xffffu); mv[1] = __uint_as_float(mq.x & 0xffff0000u); mv[2] = bf2f(mq.y & 0xffffu); mv[3] = __uint_as_float(mq.y & 0xffff0000u); }
            float o[4];
#pragma unroll
            for (int i = 0; i < 4; ++i) o[i] = MODE == 0 ? gv[i] * sigmoidf_(v[i]) : (MODE == 1 ? mv[i] * v[i] : mv[i] + gv[i] * v[i]);
            u32x2 ov; ov.x = pk2(o[0], o[1]); ov.y = pk2(o[2], o[3]); *mp = ov; });
    }
};
struct EpiMergeCP {
    bf16_t* Mg; const bf16_t* GT;
    __device__ __forceinline__ void operator()(f32x4 (&acc)[2][2][4][2], const Unit& u, int wr, int wc, int fr, int fq) const {
        const int mode = u.batch; const int goff = mode == 0 ? 1024 : (mode == 1 ? 0 : 2048);
#pragma unroll
        for (int ai = 0; ai < 2; ++ai)
#pragma unroll
            for (int m = 0; m < 4; ++m) {
                const size_t r = (size_t)(u.pm * 256 + ai * 128 + wr * 64 + m * 16 + fr); const int c = u.pn * 128 + wc * 32 + 8 * fq;
                const u32x4 gq = *(const u32x4*)(GT + r * 3072 + goff + c);
                float gf[8]; unpack8(gq, gf);
                const f32x4 g0 = {gf[0], gf[1], gf[2], gf[3]}, g1 = {gf[4], gf[5], gf[6], gf[7]};
                const f32x4 v0 = acc[ai][1][m][0], v1 = acc[ai][1][m][1]; f32x4 M0 = acc[ai][0][m][0], M1 = acc[ai][0][m][1];
                if (mode == 0) {
#pragma unroll
                    for (int i = 0; i < 4; ++i) { M0[i] = g0[i] * sigmoidf_(M0[i]) * v0[i]; M1[i] = g1[i] * sigmoidf_(M1[i]) * v1[i]; }
                } else { M0 += g0 * v0; M1 += g1 * v1; }
                if (mode == 2) { u32x4 ov; ov.x = pk2(M0[0], M0[1]); ov.y = pk2(M0[2], M0[3]); ov.z = pk2(M1[0], M1[1]); ov.w = pk2(M1[2], M1[3]); *(u32x4*)(Mg + r * DM + c) = ov; }
                acc[ai][0][m][0] = M0; acc[ai][0][m][1] = M1;
            }
    }
};
struct EpiMergeHalf {
    bf16_t* Mg; const bf16_t* GT;
    __device__ __forceinline__ void operator()(f32x4 (&acc)[2][2][4][2], const Unit& u, int wr, int wc, int fr, int fq) const {
        const int mode = u.batch; const int goff = mode == 1 ? 1024 : (mode == 2 ? 0 : 2048);
#pragma unroll
        for (int m = 0; m < 4; ++m)
#pragma unroll
            for (int bj = 0; bj < 2; ++bj) {
                const size_t r = (size_t)(u.pm * 128 + wr * 64 + m * 16 + fr); const int c = u.pn * 256 + bj * 128 + wc * 32 + 8 * fq;
                const f32x4 v0 = acc[0][bj][m][0], v1 = acc[0][bj][m][1]; f32x4 M0 = acc[1][bj][m][0], M1 = acc[1][bj][m][1];
                if (mode == 0) {
#pragma unroll
                    for (int i = 0; i < 4; ++i) { M0[i] = sigmoidf_(v0[i]); M1[i] = sigmoidf_(v1[i]); }
                } else {
                    const u32x4 gq = *(const u32x4*)(GT + r * 3072 + goff + c);
                    float gf[8]; unpack8(gq, gf);
                    const f32x4 g0 = {gf[0], gf[1], gf[2], gf[3]}, g1 = {gf[4], gf[5], gf[6], gf[7]};
                    if (mode == 1) { M0 = M0 * v0 * g0; M1 = M1 * v1 * g1; } else { M0 += g0 * v0; M1 += g1 * v1; }
                    if (mode == 3) { u32x4 ov; ov.x = pk2(M0[0], M0[1]); ov.y = pk2(M0[2], M0[3]); ov.z = pk2(M1[0], M1[1]); ov.w = pk2(M1[2], M1[3]); *(u32x4*)(Mg + r * DM + c) = ov; }
                }
                acc[1][bj][m][0] = M0; acc[1][bj][m][1] = M1;
            }
    }
};
struct EpiMergeAll {
    bf16_t* Mg; const bf16_t* GT;
    __device__ __forceinline__ void operator()(const f32x4 (&acc)[2][2][4][2], const Unit& u, int wr, int wc, int fr, int fq) const {
        const int mode = u.batch; const int goff = mode == 0 ? 1024 : (mode == 2 ? 0 : 2048);
        pg8::epi_foreach(acc, wr, wc, fr, fq, [&](int rl, int cl, const f32x4& v) {
            const size_t r = (size_t)(u.pm * 256 + rl); const int c = u.pn * 256 + cl;
            u32x2* mp = (u32x2*)(Mg + r * DM + c);
            u32x2 gq = {0x3f803f80u, 0x3f803f80u}, mq = {0u, 0u};
            if (mode != 1) gq = *(const u32x2*)(GT + r * 3072 + goff + c);
            if (mode != 0) mq = *mp;
            const float g0 = bf2f(gq.x & 0xffffu), g1 = __uint_as_float(gq.x & 0xffff0000u), g2 = bf2f(gq.y & 0xffffu), g3 = __uint_as_float(gq.y & 0xffff0000u);
            const float m0 = bf2f(mq.x & 0xffffu), m1 = __uint_as_float(mq.x & 0xffff0000u), m2 = bf2f(mq.y & 0xffffu), m3 = __uint_as_float(mq.y & 0xffff0000u);
            float t0 = v[0], t1 = v[1], t2 = v[2], t3 = v[3];
            if (mode == 0) { t0 = sigmoidf_(t0); t1 = sigmoidf_(t1); t2 = sigmoidf_(t2); t3 = sigmoidf_(t3); }
            float o0, o1, o2, o3;
            if (mode == 1) { o0 = m0 * t0; o1 = m1 * t1; o2 = m2 * t2; o3 = m3 * t3; }
            else { o0 = m0 + g0 * t0; o1 = m1 + g1 * t1; o2 = m2 + g2 * t2; o3 = m3 + g3 * t3; }
            u32x2 ov; ov.x = pk2(o0, o1); ov.y = pk2(o2, o3); *mp = ov; });
    }
};
struct EpiResid {
    float* xc; float* out; const float* mods_l; int gi; float* PB;
    __device__ __forceinline__ void operator()(const f32x4 (&acc)[2][2][4][2], const Unit& u, int wr, int wc, int fr, int fq) const {
        const TileRows tr(u.pm);
        float* xb = tr.tb == 0 ? xc + (size_t)tr.b * CTXL * DM : out + ((size_t)tr.b * SEQ + (tr.tb - 1) * 256) * DM;
        const float* gate = mods_l + (size_t)(tr.tb == 0 ? 8 : tr.b) * 6144 + gi * DM;
        if (u.batch == 0) {
            pg8::epi_foreach(acc, wr, wc, fr, fq, [&](int rl, int cl, const f32x4& v) {
                const int c = u.pn * 256 + cl; float* p = xb + (size_t)rl * DM + c;
                const f32x4 gt = *(const f32x4*)(gate + c); f32x4 xv = *(f32x4*)p; xv += gt * v; *(f32x4*)p = xv; });
        } else {
            float* pb = PB + (size_t)((u.batch - 1) * 32 + u.aux) * 65536;
            pg8::epi_foreach(acc, wr, wc, fr, fq, [&](int rl, int cl, const f32x4& v) {
                const f32x4 gt = *(const f32x4*)(gate + u.pn * 256 + cl); *(f32x4*)(pb + rl * 256 + cl) = gt * v; });
        }
    }
};
struct EpiSqRelu {
    bf16_t* Hd;
    __device__ __forceinline__ void operator()(const f32x4 (&acc)[2][2][4][2], const Unit& u, int wr, int wc, int fr, int fq) const {
        pg8::epi_foreach(acc, wr, wc, fr, fq, [&](int rl, int cl, const f32x4& v) {
            float o[4];
#pragma unroll
            for (int i = 0; i < 4; ++i) { const float r = fmaxf(v[i], 0.f); o[i] = r * r; }
            u32x2 ov; ov.x = pk2(o[0], o[1]); ov.y = pk2(o[2], o[3]);
            *(u32x2*)(Hd + (size_t)(u.pm * 256 + rl) * HID + u.pn * 256 + cl) = ov; });
    }
};

__device__ __forceinline__ void transpose_item(const float* W, int K, int N, bf16_t* WT, LAS float* scr, int item, int lane, bool blk = false) {
    const int nblk = N / 32, kb = item / nblk, nbk = item - kb * nblk, k0 = 64 * kb, n0 = 32 * nbk;
#pragma unroll 8
    for (int i = 0; i < 32; ++i) { const int kk = 2 * i + (lane >> 5); scr[kk * 33 + (lane & 31)] = W[(size_t)(k0 + kk) * N + n0 + (lane & 31)]; }
    asm volatile("s_waitcnt lgkmcnt(0)" ::: "memory");
    const int c = lane & 7;
#pragma unroll
    for (int j = 0; j < 4; ++j) { const int n = (lane >> 3) + 8 * j; const LAS float* s = scr + (8 * c) * 33 + n;
        u32x4 o; o.x = pk2(s[0 * 33], s[1 * 33]); o.y = pk2(s[2 * 33], s[3 * 33]); o.z = pk2(s[4 * 33], s[5 * 33]); o.w = pk2(s[6 * 33], s[7 * 33]);
        *(u32x4*)(blk ? WT + ((size_t)kb * N + (n0 + n)) * 64 + 8 * c : WT + (size_t)(n0 + n) * K + k0 + 8 * c) = o; }
    asm volatile("s_waitcnt lgkmcnt(0)" ::: "memory");
}

__device__ __forceinline__ void build_tmap(LAS unsigned char* tmap) {
    const int tid = tid_();
    for (int i = tid; i < 544; i += 512) tmap[i] = 0xff;
    __syncthreads();
    if (tid < 32) { int pm, pn; pg8::std_map(512 + tid, 136, 4, pm, pn); tmap[pm * 4 + pn] = (unsigned char)tid; }
    __syncthreads();
}
__device__ __forceinline__ bool fold_partials(f32x4 (&v)[4], const LAS unsigned char* tmap, const float* PB, int r, int lane) {
    const int pm = r >> 8, rl = r & 255; bool any = false;
#pragma unroll
    for (int j = 0; j < 4; ++j) { const int q = tmap[pm * 4 + j];
        if (q != 0xff) { any = true;
#pragma unroll
            for (int sl = 0; sl < 4; ++sl) v[j] += *(const f32x4*)(PB + ((size_t)(sl * 32 + q) * 256 + rl) * 256 + lane * 4); } }
    return any;
}
__device__ __forceinline__ void prenorm_row(float* xr, const float* g, const float* shift, const float* scale, bf16_t* orow, int lane, const LAS unsigned char* tmap, const float* PB, int r) {
    f32x4 v[4]; float s = 0.f;
#pragma unroll
    for (int j = 0; j < 4; ++j) v[j] = ((const f32x4*)xr)[lane + 64 * j];
    if (PB) { if (fold_partials(v, tmap, PB, r, lane)) {
#pragma unroll
        for (int j = 0; j < 4; ++j) ((f32x4*)xr)[lane + 64 * j] = v[j]; } }
#pragma unroll
    for (int j = 0; j < 4; ++j) s += (v[j].x * v[j].x + v[j].y * v[j].y) + (v[j].z * v[j].z + v[j].w * v[j].w);
    const float rstd = rsqrtf(wave_sum(s) * (1.f / DM) + 1e-6f);
#pragma unroll
    for (int j = 0; j < 4; ++j) {
        const f32x4 gg = ((const f32x4*)g)[lane + 64 * j], sh = ((const f32x4*)shift)[lane + 64 * j], sc = ((const f32x4*)scale)[lane + 64 * j];
        const f32x4 y = v[j] * rstd * gg * (sc + 1.f) + sh;
        u32x2 o; o.x = pk2(y.x, y.y); o.y = pk2(y.z, y.w);
        ((u32x2*)orow)[lane + 64 * j] = o;
    }
}
__device__ __forceinline__ void prenorm_all(KArgs& a, LAS unsigned char* lds, const float* g, const float* mods_l, int si, bf16_t* Hn, const float* PB) {
    LAS unsigned char* tmap = lds + 140000;
    if (PB) build_tmap(tmap);
    const int lane = tid_() & 63, gw = bid_() * 8 + (tid_() >> 6), ngw = nblk_() * 8;
    for (int r = gw; r < MTOK; r += ngw) {
        const int b = r / TPB, t = r - b * TPB; const float* md = mods_l + (size_t)(t < CTXL ? 8 : b) * 6144;
        prenorm_row(xrow(a, r), g, md + si * DM, md + (si + 1) * DM, Hn + (size_t)r * DM, lane, tmap, PB, r);
    }
}

__device__ __forceinline__ void phase_pre(KArgs& a, LAS unsigned char* lds) {
    const int tid = tid_(), bid = bid_();
    {
        LAS float* s = (LAS float*)lds;
        LAS float* red = (LAS float*)(lds + 36864);
        for (int i = tid; i < 9 * 1024; i += 512) { const int j = i >> 10, k = i & 1023; const float v = (j < 8) ? a.c[j * 1024 + k] : a.c_ctx[k]; s[i] = v / (1.f + __expf(-v)); }
        __syncthreads();
        const int cl = tid & 127, kq = tid >> 7;
        for (int task = bid; task < 4 * 48; task += nblk_()) {
            const int n = task * 128 + cl, l = n / 6144, col = n - l * 6144;
            const float* w = a.w_mod + (size_t)l * 1024 * 6144 + col + (size_t)kq * 256 * 6144;
            float acc[9];
#pragma unroll
            for (int j = 0; j < 9; ++j) acc[j] = 0.f;
#pragma unroll 8
            for (int k = 0; k < 256; ++k) { const float wv = w[(size_t)k * 6144];
#pragma unroll
                for (int j = 0; j < 9; ++j) acc[j] += s[j * 1024 + kq * 256 + k] * wv; }
#pragma unroll
            for (int j = 0; j < 9; ++j) red[(kq * 9 + j) * 128 + cl] = acc[j];
            __syncthreads();
            float* mods = (float*)(a.ws + OFF_MODS);
            for (int i = tid; i < 9 * 128; i += 512) { const int j = i >> 7, c2 = i & 127, n2 = task * 128 + c2, l2 = n2 / 6144, col2 = n2 - l2 * 6144;
                mods[(size_t)(l2 * 9 + j) * 6144 + col2] = red[(0 * 9 + j) * 128 + c2] + red[(1 * 9 + j) * 128 + c2] + red[(2 * 9 + j) * 128 + c2] + red[(3 * 9 + j) * 128 + c2] + a.b_mod[l2 * 6144 + col2]; }
            __syncthreads();
        }
    }
    const size_t gt = (size_t)bid * 512 + tid, gn = (size_t)nblk_() * 512;
    for (size_t i = gt; i < (size_t)NB * SEQ * DM / 4; i += gn) ((f32x4*)a.out)[i] = ((const f32x4*)a.x)[i];
    for (size_t i = gt; i < (size_t)NB * CTXL * DM / 4; i += gn) ((f32x4*)(a.ws + OFF_XC))[i] = ((const f32x4*)a.ctx)[i];
    f32x2* AP = (f32x2*)(a.ws + OFF_AP); f32x2* BB = (f32x2*)(a.ws + OFF_BB);
    for (size_t e = gt; e < (size_t)4 * 2 * 32 * 64 * 33; e += gn) {
        const int idx = (int)(e / 33), d = (int)(e - (size_t)idx * 33);
        const float lr = fminf(a.lam_re[idx], -1e-4f), li = a.lam_im[idx], dt = expf(a.log_step[idx >> 6]);
        const float mag = expf(lr * dt * (float)d); float sn, cs; sincosf(li * dt * (float)d, &sn, &cs);
        AP[e] = (f32x2){mag * cs, mag * sn};
    }
    for (size_t e = gt; e < (size_t)4 * 2 * 32 * 64 * 16; e += gn) {
        const int idx = (int)(e >> 4);
        const float lr = fminf(a.lam_re[idx], -1e-4f), li = a.lam_im[idx], dt = expf(a.log_step[idx >> 6]);
        const float mag = expf(lr * dt); float sn, cs; sincosf(li * dt, &sn, &cs);
        const float nr = mag * cs - 1.f, ni = mag * sn, den = lr * lr + li * li;
        const float qr = (nr * lr + ni * li) / den, qi = (ni * lr - nr * li) / den;
        const float br = a.b_re[e], bi = a.b_im[e];
        BB[e] = (f32x2){qr * br - qi * bi, qr * bi + qi * br};
    }
}

__device__ __forceinline__ void weight_transposes(KArgs& a, LAS unsigned char* lds, int l, int it_lo, int it_hi, int blk0, int nblk) {
    const int tid = tid_(), lane = tid & 63, wave = tid >> 6, gw = (bid_() - blk0) * 8 + wave, ngw = nblk * 8;
    LAS float* scr = (LAS float*)(lds + wave * 8448);
    bf16_t* WA = (bf16_t*)(a.ws + OFF_WA); bf16_t* WB = (bf16_t*)(a.ws + OFF_WB);
    for (int it = it_lo + gw; it < it_hi; it += ngw) {
        int r = it, K, N; const float* W; bf16_t* WT; bool blk = false;
        if (r < 3328) { W = a.w_in + (size_t)l * DM * INW; K = DM; N = INW; WT = WA + WA_WIN / 2; }
        else if ((r -= 3328) < 256) { W = a.conv_out + (size_t)l * 512 * DM; K = 512; N = DM; WT = WA + WA_CONV / 2; }
        else if ((r -= 256) < 256) { W = a.glu_a + (size_t)l * 512 * DM; K = 512; N = DM; WT = WA + WA_GLUA / 2; }
        else if ((r -= 256) < 256) { W = a.glu_b + (size_t)l * 512 * DM; K = 512; N = DM; WT = WA + WA_GLUB / 2; }
        else if ((r -= 256) < 256) { W = a.na_out + (size_t)l * 512 * DM; K = 512; N = DM; WT = WA + WA_NA / 2; }
        else if ((r -= 256) < 512) { W = a.w_out + (size_t)l * DM * DM; K = DM; N = DM; WT = WA + WA_WOUT / 2; }
        else if ((r -= 512) < 2048) { W = a.mlp_w1 + (size_t)l * DM * HID; K = DM; N = HID; WT = WB; }
        else { r -= 2048; W = a.mlp_w2 + (size_t)l * HID * DM; K = HID; N = DM; WT = WB + (size_t)HID * DM; blk = true; }
        transpose_item(W, K, N, WT, scr, r, lane, blk);
    }
}
__device__ __forceinline__ void s5_tables(KArgs& a, int l, int blk0, int nblk) {
    const int tid = tid_();
    const size_t gt = (size_t)(bid_() - blk0) * 512 + tid, gn = (size_t)nblk * 512;
    const f32x2* AP = (const f32x2*)(a.ws + OFF_AP) + (size_t)l * 2 * 32 * 64 * 33;
    const f32x2* BB = (const f32x2*)(a.ws + OFF_BB) + (size_t)l * 2 * 32 * 64 * 16;
    const float* cre = a.c_re + (size_t)l * 2 * 32 * 16 * 64; const float* cim = a.c_im + (size_t)l * 2 * 32 * 16 * 64;
    float* KT = (float*)(a.ws + OFF_KTAB);
    for (size_t e = gt; e < (size_t)32 * 2 * 32 * 16 * 4; e += gn) {
        const int mq = (int)(e & 3), n = (int)((e >> 2) & 15), d = (int)((e >> 6) & 31), dir = (int)((e >> 11) & 1), gI = (int)(e >> 12);
        const int dg = dir * 32 + gI; f32x4 acc = {0.f, 0.f, 0.f, 0.f};
#pragma unroll 8
        for (int p = 0; p < 64; ++p) {
            const f32x2 ap = AP[((size_t)dg * 64 + p) * 33 + d];
            const f32x4 b01 = *(const f32x4*)(BB + ((size_t)dg * 64 + p) * 16 + 4 * mq), b23 = *(const f32x4*)(BB + ((size_t)dg * 64 + p) * 16 + 4 * mq + 2);
            const float cr = cre[((size_t)dg * 16 + n) * 64 + p], ci = cim[((size_t)dg * 16 + n) * 64 + p];
            const float wr_ = cr * ap.x - ci * ap.y, wi_ = cr * ap.y + ci * ap.x;
            acc[0] += wr_ * b01[0] - wi_ * b01[1]; acc[1] += wr_ * b01[2] - wi_ * b01[3];
            acc[2] += wr_ * b23[0] - wi_ * b23[1]; acc[3] += wr_ * b23[2] - wi_ * b23[3];
        }
        *(f32x4*)(KT + ((((size_t)gI * 2 + dir) * 32 + d) * 16 + n) * 16 + 4 * mq) = acc;
    }
    bf16_t* WET = (bf16_t*)(a.ws + OFF_WET);
    for (size_t e = gt; e < (size_t)32 * 256 * 64; e += gn) {
        const int k8 = (int)(e & 63), col = (int)((e >> 6) & 255), gI = (int)(e >> 14);
        const int dir = col >> 7, part = (col >> 6) & 1, p = col & 63, s = k8 >> 1, m0 = (k8 & 1) * 8, dg = dir * 32 + gI;
        const f32x2 ap = AP[((size_t)dg * 64 + p) * 33 + (dir == 0 ? TCH - 1 - s : s)];
        const f32x4* bbp = (const f32x4*)(BB + ((size_t)dg * 64 + p) * 16 + m0);
        float z[8];
#pragma unroll
        for (int i = 0; i < 4; ++i) { const f32x4 bb = bbp[i];
            z[2 * i] = part == 0 ? ap.x * bb[0] - ap.y * bb[1] : ap.x * bb[1] + ap.y * bb[0];
            z[2 * i + 1] = part == 0 ? ap.x * bb[2] - ap.y * bb[3] : ap.x * bb[3] + ap.y * bb[2]; }
        u32x4 o; o.x = pk2(z[0], z[1]); o.y = pk2(z[2], z[3]); o.z = pk2(z[4], z[5]); o.w = pk2(z[6], z[7]);
        *(u32x4*)(WET + ((size_t)gI * 256 + col) * 512 + k8 * 8) = o;
    }
    bf16_t* BTY = (bf16_t*)(a.ws + OFF_BTY);
    for (size_t e = gt; e < (size_t)32 * 512 * 32; e += gn) {
        const int j8 = (int)(e & 31), row = (int)((e >> 5) & 511), gI = (int)(e >> 14);
        const int dir = j8 >> 4, part = (j8 >> 3) & 1, p0 = (j8 & 7) * 8, t = row >> 4, n = row & 15, dg = dir * 32 + gI, idx = dir == 0 ? t + 1 : TCH - t;
        const f32x4 cr0 = *(const f32x4*)(cre + ((size_t)dg * 16 + n) * 64 + p0), cr1 = *(const f32x4*)(cre + ((size_t)dg * 16 + n) * 64 + p0 + 4);
        const f32x4 ci0 = *(const f32x4*)(cim + ((size_t)dg * 16 + n) * 64 + p0), ci1 = *(const f32x4*)(cim + ((size_t)dg * 16 + n) * 64 + p0 + 4);
        float z[8];
#pragma unroll
        for (int i = 0; i < 8; ++i) { const f32x2 ap = AP[((size_t)dg * 64 + p0 + i) * 33 + idx];
            const float cr = i < 4 ? cr0[i & 3] : cr1[i & 3], ci = i < 4 ? ci0[i & 3] : ci1[i & 3];
            z[i] = part == 0 ? cr * ap.x - ci * ap.y : -(cr * ap.y + ci * ap.x); }
        u32x4 o; o.x = pk2(z[0], z[1]); o.y = pk2(z[2], z[3]); o.z = pk2(z[4], z[5]); o.w = pk2(z[6], z[7]);
        *(u32x4*)(BTY + ((size_t)gI * 512 + row) * 768 + 512 + j8 * 8) = o;
    }
}
__device__ __forceinline__ void phase_a(KArgs& a, LAS unsigned char* lds, int l) {
    const int nb = nblk_();
    if (l == 0 || nb != 256) { weight_transposes(a, lds, l, 0, 8960, 0, nb); s5_tables(a, l, 0, nb); }
    else weight_transposes(a, lds, l, 4864, 8960, 0, nb);
    const float* mods_l = (const float*)(a.ws + OFF_MODS) + (size_t)l * 9 * 6144;
    __syncthreads();
    prenorm_all(a, lds, a.norm1_g + l * DM, mods_l, 0, (bf16_t*)(a.ws + OFF_HN), (l > 0 && nblk_() == 256) ? (const float*)(a.ws + OFF_A2) : nullptr);
}

__device__ __forceinline__ void toeplitz_fill(KArgs& a, int l) {
    const size_t gt = (size_t)bid_() * 512 + tid_(), gn = (size_t)nblk_() * 512;
    const float* KT = (const float*)(a.ws + OFF_KTAB); bf16_t* BTY = (bf16_t*)(a.ws + OFF_BTY);
    const float* dsk = a.s5_d + l * 512;
    for (size_t e = gt; e < (size_t)32 * 512 * 64; e += gn) {
        const int k8 = (int)(e & 63), row = (int)((e >> 6) & 511), gI = (int)(e >> 15);
        const int t = row >> 4, n = row & 15, s = k8 >> 1, m0 = (k8 & 1) * 8;
        float v[8];
        if (s == t) {
            const float* kf = KT + ((((size_t)gI * 2 + 0) * 32 + 0) * 16 + n) * 16 + m0; const float* kb = KT + ((((size_t)gI * 2 + 1) * 32 + 0) * 16 + n) * 16 + m0;
#pragma unroll
            for (int i = 0; i < 8; ++i) v[i] = kf[i] + kb[i] + ((m0 + i) == n ? dsk[gI * 16 + n] : 0.f);
        } else {
            const int dir = s < t ? 0 : 1, d = s < t ? t - s : s - t;
            const float* kk = KT + ((((size_t)gI * 2 + dir) * 32 + d) * 16 + n) * 16 + m0;
#pragma unroll
            for (int i = 0; i < 8; ++i) v[i] = kk[i];
        }
        u32x4 o; o.x = pk2(v[0], v[1]); o.y = pk2(v[2], v[3]); o.z = pk2(v[4], v[5]); o.w = pk2(v[6], v[7]);
        *(u32x4*)(BTY + ((size_t)gI * 512 + row) * 768 + k8 * 8) = o;
    }
}

__device__ __forceinline__ void carry_scan(KArgs& a, int l) {
    int gt;
    if (nblk_() * 128 >= 8 * 32 * 2 * 64) { if (tid_() >= 128) return; gt = bid_() * 128 + tid_(); } else gt = bid_() * 512 + tid_();
    if (gt >= 8 * 32 * 2 * 64) return;
    const int p = gt & 63, dir = (gt >> 6) & 1, gI = (gt >> 7) & 31, b = gt >> 12;
    const f32x2 aT = ((const f32x2*)(a.ws + OFF_AP))[((((size_t)l * 2 + dir) * 32 + gI) * 64 + p) * 33 + TCH];
    const float* E = (const float*)(a.ws + OFF_R2 + SZ_ACT) + ((size_t)gI * NCR + b * CPB) * 256 + dir * 128 + p;
    bf16_t* H = (bf16_t*)(a.ws + OFF_A2) + ((size_t)gI * NCR + b * CPB) * 768 + 512 + dir * 128 + p;
    float hr = 0.f, hi = 0.f;
    for (int i0 = 0; i0 < CPB; i0 += 8) {
        float er[8], ei[8]; int cc[8];
#pragma unroll
        for (int j = 0; j < 8; ++j) { const int i = i0 + j; cc[j] = dir == 0 ? i : (i < 8 ? 7 - i : CPB + 7 - i); er[j] = E[(size_t)cc[j] * 256]; ei[j] = E[(size_t)cc[j] * 256 + 64]; }
#pragma unroll
        for (int j = 0; j < 8; ++j) {
            H[(size_t)cc[j] * 768] = (bf16_t)(pk2(hr, 0.f) & 0xffffu); H[(size_t)cc[j] * 768 + 64] = (bf16_t)(pk2(hi, 0.f) & 0xffffu);
            const float nr = aT.x * hr - aT.y * hi + er[j], ni = aT.x * hi + aT.y * hr + ei[j]; hr = nr; hi = ni;
        }
    }
}

__device__ __forceinline__ void conv_all(KArgs& a, int l) {
    const size_t gt = (size_t)bid_() * 512 + tid_(), gn = (size_t)nblk_() * 512;
    const bf16_t* PA = (const bf16_t*)(a.ws + OFF_R1); bf16_t* AC = (bf16_t*)(a.ws + OFF_R2);
    const float* cw = a.conv_w + l * 3 * 512;
    for (size_t e = gt; e < (size_t)MTOK * 64; e += gn) {
        const int r = (int)(e >> 6), c0 = (int)(e & 63) * 8; const int t = r % TPB;
        const bf16_t* pr = PA + (size_t)r * PALD + c0;
        float xa[8], xb[8], xc[8], vm[8], vp[8];
        unpack8(*(const u32x4*)pr, xa); unpack8(*(const u32x4*)(pr + 512), xb); unpack8(*(const u32x4*)(pr + 1024), xc);
        const bool hasm = (t != 0 && t != CTXL), hasp = (t != CTXL - 1 && t != TPB - 1);
        if (hasm) { float q1[8], q2[8]; unpack8(*(const u32x4*)(pr - PALD), q1); unpack8(*(const u32x4*)(pr - PALD + 1024), q2);
#pragma unroll
            for (int i = 0; i < 8; ++i) vm[i] = q1[i] * q2[i]; }
        else {
#pragma unroll
            for (int i = 0; i < 8; ++i) vm[i] = 0.f; }
        if (hasp) { float q1[8], q2[8]; unpack8(*(const u32x4*)(pr + PALD), q1); unpack8(*(const u32x4*)(pr + PALD + 1024), q2);
#pragma unroll
            for (int i = 0; i < 8; ++i) vp[i] = q1[i] * q2[i]; }
        else {
#pragma unroll
            for (int i = 0; i < 8; ++i) vp[i] = 0.f; }
        float o[8];
#pragma unroll
        for (int i = 0; i < 8; ++i) o[i] = xb[i] * (cw[c0 + i] * vm[i] + cw[512 + c0 + i] * (xa[i] * xc[i]) + cw[1024 + c0 + i] * vp[i]);
        u32x4 ov; ov.x = pk2(o[0], o[1]); ov.y = pk2(o[2], o[3]); ov.z = pk2(o[4], o[5]); ov.w = pk2(o[6], o[7]);
        *(u32x4*)(AC + (size_t)r * 512 + c0) = ov;
    }
}

#define MFMA32(a, b, c) __builtin_amdgcn_mfma_f32_32x32x16_bf16((a), (b), (c), 0, 0, 0)
__device__ __forceinline__ void attn_dma_tile(const bf16_t* KHb, const bf16_t* VTb, int tt, int lane, LAS unsigned char* buf) {
    const int kl = lane >> 3, pos = lane & 7;
#pragma unroll
    for (int i = 0; i < 4; ++i) __builtin_amdgcn_global_load_lds((const unsigned*)(KHb + (size_t)(tt + 8 * i + kl) * 64 + ((pos ^ kl ^ (i & 1)) << 3)), (LAS unsigned*)(buf + i * 1024), 16, 0, 0);
    const bf16_t* vp = VTb + ((size_t)(tt >> 3) * 64 + lane) * 8;
#pragma unroll
    for (int j = 0; j < 4; ++j) __builtin_amdgcn_global_load_lds((const unsigned*)(vp + (size_t)j * 512), (LAS unsigned*)(buf + 4096 + j * 1024), 16, 0, 0);
}
__device__ __forceinline__ void attn_read_tile(const LAS unsigned char* buf, int lane, int q32, int g, bf16x8 (&kf)[4], bf16x8 (&vf)[2][2]) {
    const int ki = q32 >> 3, kl = q32 & 7;
#pragma unroll
    for (int ks = 0; ks < 4; ++ks) kf[ks] = *(const LAS bf16x8*)(buf + ki * 1024 + (kl * 8 + ((2 * ks + g) ^ kl ^ (ki & 1))) * 16);
#pragma unroll
    for (int d = 0; d < 2; ++d)
#pragma unroll
        for (int s2 = 0; s2 < 2; ++s2) {
            const u32x4 c0 = *(const LAS u32x4*)(buf + 4096 + (2 * s2) * 1024 + (32 * d + q32) * 16), c1 = *(const LAS u32x4*)(buf + 4096 + (2 * s2 + 1) * 1024 + (32 * d + q32) * 16);
            const u32x4 w = {g ? c0.z : c0.x, g ? c0.w : c0.y, g ? c1.z : c1.x, g ? c1.w : c1.y}; vf[d][s2] = __builtin_bit_cast(bf16x8, w);
        }
}
__device__ __forceinline__ void attn_all(KArgs& a, LAS unsigned char* lds, int l) {
    const int tid = tid_(), lane = tid & 63, wave = __builtin_amdgcn_readfirstlane(tid >> 6), q32 = lane & 31, g = lane >> 5;
    LAS float* rpb_s = (LAS float*)(lds + 1024);
    for (int i = tid; i < 3720; i += 512) rpb_s[i] = a.na_rpb[l * 3720 + i] * 1.44269504f;
    LAS unsigned char* wbuf = lds + 16384 + wave * 16384;
    __syncthreads();
    const bf16_t* PA = (const bf16_t*)(a.ws + OFF_R1); const bf16_t* VT = (const bf16_t*)(a.ws + OFF_VT); const bf16_t* KH = (const bf16_t*)(a.ws + OFF_KH); bf16_t* OA = (bf16_t*)(a.ws + OFF_R2 + 2 * SZ_ACT);
    const int nb = nblk_(), bid = nb - 1 - bid_(), ntb = 1024 + (l < DEPTH - 1 ? 64 : 0);
    const bool xl = (nb & 7) == 0;
    const int gw = xl ? (bid >> 3) * 8 + wave : bid * 8 + wave, ngw = xl ? nb : nb * 8, tend = xl ? ntb : 8 * ntb;
    for (int ti = gw; ti < tend; ti += ngw) {
        const int b = xl ? (bid & 7) : ti / ntb, task = xl ? ti : ti - b * ntb;
        int h, qtok, n_local = 0, krow_lo = 0, tc0 = 0, qrow_g = 0, qcol = 0, r0q = 0;
        float cadd[16];
#pragma unroll
        for (int j = 0; j < 16; ++j) cadd[j] = 0.f;
        if (task < 1024) {
            h = task & 7; const int cb = (task >> 3) & 3, rp = task >> 5;
            const int rr0 = 2 * rp; qrow_g = rr0 + (q32 >> 4); qcol = cb * 16 + (q32 & 15);
            qtok = b * TPB + CTXL + qrow_g * 64 + qcol;
            r0q = min(max(qrow_g - 4, 0), 56); const int csq = min(max(qcol - 8, 0), 48);
            tc0 = min(max(cb * 16 - 8, 0), 32);
            krow_lo = min(max(rr0 - 4, 0), 56); n_local = min(max(rr0 - 3, 0), 56) + 8 - krow_lo;
#pragma unroll
            for (int j = 0; j < 16; ++j) { const int ko = 8 * (j >> 2) + 4 * g + (j & 3); cadd[j] = (unsigned)(tc0 + ko - csq) < 16u ? 0.f : -1e30f; }
        } else { const int j = task - 1024; h = j & 7; qtok = b * TPB + (j >> 3) * 32 + q32; }
        const bf16_t* KHb = KH + (size_t)(b * 8 + h) * TPB * 64; const bf16_t* VTb = VT + (size_t)(b * 8 + h) * 544 * 512;
        bf16x8 qf[4];
        { const bf16_t* qp = PA + (size_t)qtok * PALD + 1536 + h * 64 + g * 8;
#pragma unroll
          for (int ks = 0; ks < 4; ++ks) qf[ks] = *(const bf16x8*)(qp + ks * 16); }
        f32x16 O0, O1;
#pragma unroll
        for (int j = 0; j < 16; ++j) { O0[j] = 0.f; O1[j] = 0.f; }
        float mrun = -1e29f, lsum = 0.f;
        const int ntiles = n_local + 8;
        const LAS float* bp0 = rpb_s + h * 465 + (7 - qrow_g) * 31 + (tc0 + 4 * g - qcol + 15);
        auto tile_tt = [&](int t) { const int tc = t < ntiles ? t : ntiles - 1; return tc < n_local ? CTXL + (krow_lo + tc) * 64 + tc0 : (tc - n_local) * 32; };
        auto process = [&](int t) {
            asm volatile("s_waitcnt vmcnt(8)" ::: "memory");
            bf16x8 kf[4], vf[2][2];
            attn_read_tile(wbuf + (t & 1) * 8192, lane, q32, g, kf, vf);
            f32x16 S;
#pragma unroll
            for (int j = 0; j < 16; ++j) S[j] = 0.f;
#pragma unroll
            for (int ks = 0; ks < 4; ++ks) S = MFMA32(kf[ks], qf[ks], S);
            asm volatile("s_waitcnt lgkmcnt(0)" ::: "memory");
            attn_dma_tile(KHb, VTb, tile_tt(t + 2), lane, wbuf + (t & 1) * 8192);
            float sv[16];
            if (t < n_local) {
                const int krow = krow_lo + t; const float radd = (unsigned)(krow - r0q) < 8u ? 0.f : -1e30f;
                const LAS float* bp = bp0 + krow * 31;
                float bv[16];
#pragma unroll
                for (int j = 0; j < 16; ++j) bv[j] = bp[8 * (j >> 2) + (j & 3)];
#pragma unroll
                for (int j = 0; j < 16; ++j) sv[j] = fmaf(S[j], 0.125f * 1.44269504f, bv[j] + (cadd[j] + radd));
            } else {
#pragma unroll
                for (int j = 0; j < 16; ++j) sv[j] = S[j] * (0.125f * 1.44269504f);
            }
            float mx = sv[0];
#pragma unroll
            for (int j = 1; j < 16; ++j) mx = fmaxf(mx, sv[j]);
            mx = fmaxf(mx, __shfl_xor(mx, 32));
            const float mnew = fmaxf(mrun, mx);
            if (__any(mnew > mrun)) {
                const float resc = __builtin_amdgcn_exp2f(mrun - mnew);
                lsum *= resc;
#pragma unroll
                for (int j = 0; j < 16; ++j) { O0[j] *= resc; O1[j] *= resc; }
                mrun = mnew;
            }
            float p[16], ps = 0.f;
#pragma unroll
            for (int j = 0; j < 16; ++j) { p[j] = __builtin_amdgcn_exp2f(sv[j] - mrun); ps += p[j]; }
            lsum += ps;
            const u32x4 w0 = {pk2(p[0], p[1]), pk2(p[2], p[3]), pk2(p[4], p[5]), pk2(p[6], p[7])}, w1 = {pk2(p[8], p[9]), pk2(p[10], p[11]), pk2(p[12], p[13]), pk2(p[14], p[15])};
            const bf16x8 pb0 = __builtin_bit_cast(bf16x8, w0), pb1 = __builtin_bit_cast(bf16x8, w1);
            O0 = MFMA32(vf[0][0], pb0, O0); O0 = MFMA32(vf[0][1], pb1, O0);
            O1 = MFMA32(vf[1][0], pb0, O1); O1 = MFMA32(vf[1][1], pb1, O1);
        };
        attn_dma_tile(KHb, VTb, tile_tt(0), lane, wbuf);
        attn_dma_tile(KHb, VTb, tile_tt(1), lane, wbuf + 8192);
#pragma unroll 1
        for (int t = 0; t < ntiles; ++t) process(t);
        asm volatile("s_waitcnt vmcnt(0)" ::: "memory");
        const float inv = 1.f / (lsum + __shfl_xor(lsum, 32));
        bf16_t* op = OA + (size_t)qtok * 512 + h * 64 + 4 * g;
#pragma unroll
        for (int jq = 0; jq < 4; ++jq) {
            u32x2 o0, o1; o0.x = pk2(O0[4 * jq] * inv, O0[4 * jq + 1] * inv); o0.y = pk2(O0[4 * jq + 2] * inv, O0[4 * jq + 3] * inv);
            o1.x = pk2(O1[4 * jq] * inv, O1[4 * jq + 1] * inv); o1.y = pk2(O1[4 * jq + 2] * inv, O1[4 * jq + 3] * inv);
            *(u32x2*)(op + 8 * jq) = o0; *(u32x2*)(op + 32 + 8 * jq) = o1;
        }
    }
    __syncthreads();
}

__device__ __forceinline__ void final_norm(KArgs& a) {
    const int lane = tid_() & 63, gw = bid_() * 8 + (tid_() >> 6), ngw = nblk_() * 8;
    for (int r = gw; r < NB * SEQ; r += ngw) {
        float* xr = a.out + (size_t)r * DM; f32x4 v[4]; float s = 0.f;
#pragma unroll
        for (int j = 0; j < 4; ++j) { v[j] = ((const f32x4*)xr)[lane + 64 * j]; s += (v[j].x * v[j].x + v[j].y * v[j].y) + (v[j].z * v[j].z + v[j].w * v[j].w); }
        const float rstd = rsqrtf(wave_sum(s) * (1.f / DM) + 1e-6f);
#pragma unroll
        for (int j = 0; j < 4; ++j) ((f32x4*)xr)[lane + 64 * j] = v[j] * rstd * ((const f32x4*)a.final_g)[lane + 64 * j];
    }
}

__global__ __launch_bounds__(512, 2) void mega(Args a_) {
    extern __shared__ __attribute__((aligned(16))) unsigned char shm[];
    LAS unsigned char* lds = (LAS unsigned char*)shm;
    cg::grid_group grid = cg::this_grid();
    const int ph_lo = a_.ph_lo, ph_hi = a_.ph_hi;
    int ph = 0;
    volatile LAS unsigned* xst = (volatile LAS unsigned*)(lds + 147712);
    if (threadIdx.x < 4) xst[threadIdx.x] = 0u;
    __syncthreads();
    const XcdBarrier xb = xcd_barrier_post((unsigned*)(a_.ws + OFF_BAR), xst);
#define PH_BEGIN if (ph >= ph_lo && ph < ph_hi) { KArgs* ap_ = (KArgs*)__builtin_amdgcn_kernarg_segment_ptr(); asm volatile("" : "+s"(ap_)); KArgs& a = *ap_; \
        int l = lv; asm volatile("" : "+s"(l)); int G = gridDim.x, c = blockIdx.x; asm volatile("" : "+s"(G), "+s"(c)); unsigned char* ws = a.ws; (void)l; (void)G; (void)c; (void)ws;
#ifdef PROBE_SYNC2
#define PH_END if (ph + 1 < ph_hi) { grid.sync(); grid.sync(); grid.sync(); } } ++ph;
#else
#define PH_END if (ph + 1 < ph_hi) { if (ph_hi < 0) grid.sync();   else xcd_barrier(xb); } } ++ph;
#endif
#define WSP(off) ((bf16_t*)(ws + (off)))
#ifdef PROBE_PRE2
    { const int lv = 0; PH_BEGIN phase_pre(a, lds); __syncthreads(); phase_pre(a, lds); PH_END }
#else
    { const int lv = 0; PH_BEGIN phase_pre(a, lds); PH_END }
#endif
#pragma unroll 1
    for (int lv = 0; lv < DEPTH; ++lv) {
#if !defined(ONLYP) || ONLYP == 0
#ifdef PROBE_A2
        PH_BEGIN phase_a(a, lds, l); phase_a(a, lds, l); PH_END
#else
        PH_BEGIN phase_a(a, lds, l); PH_END
#endif
#endif
#if !defined(ONLYP) || ONLYP == 1
        PH_BEGIN {
            pg8::gemm_phase<false, true>(lds, pg8::In1Prob{WSP(OFF_HN), WSP(OFF_WA + WA_WIN), DM, DM, DM, G, c}, EpiIn1P{WSP(OFF_R1), WSP(OFF_A2), WSP(OFF_VT), WSP(OFF_KH)});
#ifdef PROBE_B2
            pg8::gemm_phase<false, true>(lds, pg8::In1Prob{WSP(OFF_HN), WSP(OFF_WA + WA_WIN), DM, DM, DM, G, c}, EpiIn1P{WSP(OFF_R1), WSP(OFF_A2), WSP(OFF_VT), WSP(OFF_KH)});
#endif
            toeplitz_fill(a, l);
#ifdef PROBE_T2
            toeplitz_fill(a, l);
#endif
        } PH_END
#endif
#if !defined(ONLYP) || ONLYP == 2
        PH_BEGIN {
            pg8::gemm_phase(lds, pg8::StdProb(WSP(OFF_A2), WSP(OFF_WET), 768, 512, 512, (size_t)NCR * 768, (size_t)256 * 512, 5, 1, 32, G, c), EpiE{(float*)(ws + OFF_R2 + SZ_ACT)});
            attn_all(a, lds, l);
#ifdef PROBE_ATTN2
            attn_all(a, lds, l);
#endif
        } PH_END
#endif
#if !defined(ONLYP) || ONLYP == 3
#ifdef PROBE_D2
        PH_BEGIN carry_scan(a, l); conv_all(a, l); carry_scan(a, l); conv_all(a, l); PH_END
#else
        PH_BEGIN carry_scan(a, l); conv_all(a, l); PH_END
#endif
#endif
#if !defined(ONLYP) || ONLYP == 4
        PH_BEGIN {
            pg8::gemm_phase<false, true>(lds, pg8::StdProb(WSP(OFF_A2), WSP(OFF_BTY), 768, 768, 768, (size_t)NCR * 768, (size_t)512 * 768, 5, 2, 32, G, c), EpiYP{WSP(OFF_R2 + SZ_ACT)});
            { pg8::StdProb P(WSP(OFF_HN), WSP(OFF_WA + WA_WIN) + (size_t)3584 * DM, DM, DM, DM, 0, 0, l == DEPTH - 1 ? 128 : 136, 12, 1, G, G - 1 - c);     P.skipctx = l == DEPTH - 1;
              pg8::gemm_phase<false, true>(lds, P, EpiGatesP{WSP(OFF_R1)}); }
#ifdef PROBE_E2
            pg8::gemm_phase<false, true>(lds, pg8::StdProb(WSP(OFF_A2), WSP(OFF_BTY), 768, 768, 768, (size_t)NCR * 768, (size_t)512 * 768, 5, 2, 32, G, c), EpiYP{WSP(OFF_R2 + SZ_ACT)});
            { pg8::StdProb P(WSP(OFF_HN), WSP(OFF_WA + WA_WIN) + (size_t)3584 * DM, DM, DM, DM, 0, 0, l == DEPTH - 1 ? 128 : 136, 12, 1, G, G - 1 - c);     P.skipctx = l == DEPTH - 1;
              pg8::gemm_phase<false, true>(lds, P, EpiGatesP{WSP(OFF_R1)}); }
#endif
        } PH_END
#endif
#if !defined(ONLYP) || ONLYP == 5
        PH_BEGIN {
            pg8::gemm_phase<false, true, true>(lds, pg8::CPProb{WSP(OFF_R2), WSP(OFF_WA), 512, 512, 512, G, c, l == DEPTH - 1 ? 128 : 136}, EpiMergeCP{WSP(OFF_HN), WSP(OFF_R1)});
            if (l < DEPTH - 1 && G == 256 && c >= 64) s5_tables(a, l + 1, 64, 192);
#ifdef PROBE_F2
            pg8::gemm_phase<true, true>(lds, pg8::HalfMergeProb{WSP(OFF_R2), WSP(OFF_WA), 512, 512, 512, G, c, l == DEPTH - 1 ? 256 : 272}, EpiMergeHalf{WSP(OFF_HN), WSP(OFF_R1)});
#endif
        } PH_END
#endif
#if !defined(ONLYP) || ONLYP == 6
        PH_BEGIN {
            const EpiResid E{(float*)(ws + OFF_XC), a.out, (const float*)(ws + OFF_MODS) + (size_t)l * 9 * 6144, 2, (float*)(ws + OFF_A2)};
            if (l == DEPTH - 1) { pg8::StdProb P(WSP(OFF_HN), WSP(OFF_WA + WA_WOUT), DM, DM, DM, 0, 0, 128, 4, 1, G, c); P.skipctx = true; pg8::gemm_phase(lds, P, E); }
            else pg8::gemm_phase(lds, pg8::TailProb<4>(WSP(OFF_HN), WSP(OFF_WA + WA_WOUT), DM, DM, G, c, G == 256), E);
        } PH_END
#endif
#if !defined(ONLYP) || ONLYP == 7
#ifdef PROBE_H2
        PH_BEGIN prenorm_all(a, lds, a.norm2_g + l * DM, (const float*)(ws + OFF_MODS) + (size_t)l * 9 * 6144, 3, WSP(OFF_HN), (l < DEPTH - 1 && G == 256) ? (const float*)(ws + OFF_A2) : nullptr); prenorm_all(a, lds, a.norm2_g + l * DM, (const float*)(ws + OFF_MODS) + (size_t)l * 9 * 6144, 3, WSP(OFF_HN), (l < DEPTH - 1 && G == 256) ? (const float*)(ws + OFF_A2) : nullptr); PH_END
#else
        PH_BEGIN prenorm_all(a, lds, a.norm2_g + l * DM, (const float*)(ws + OFF_MODS) + (size_t)l * 9 * 6144, 3, WSP(OFF_HN), (l < DEPTH - 1 && G == 256) ? (const float*)(ws + OFF_A2) : nullptr); PH_END
#endif
#endif
#if !defined(ONLYP) || ONLYP == 8
        PH_BEGIN {
            { pg8::StdProb P(WSP(OFF_HN), WSP(OFF_WB), DM, DM, DM, 0, 0, l == DEPTH - 1 ? 128 : 136, 16, 1, G, c); P.skipctx = l == DEPTH - 1;
              pg8::gemm_phase<false, true>(lds, P, EpiSqReluP{WSP(OFF_R1)}); }
            if (l < DEPTH - 1 && G == 256 && c >= 128) weight_transposes(a, lds, l + 1, 0, 4864, 128, 128);
#ifdef PROBE_I2
            { pg8::StdProb P(WSP(OFF_HN), WSP(OFF_WB), DM, DM, DM, 0, 0, l == DEPTH - 1 ? 128 : 136, 16, 1, G, c); P.skipctx = l == DEPTH - 1;
              pg8::gemm_phase<false, true>(lds, P, EpiSqReluP{WSP(OFF_R1)}); }
#endif
        } PH_END
#endif
#if !defined(ONLYP) || ONLYP == 9
        PH_BEGIN {
            const EpiResid E{(float*)(ws + OFF_XC), a.out, (const float*)(ws + OFF_MODS) + (size_t)l * 9 * 6144, 5, (float*)(ws + OFF_A2)};
            if (l == DEPTH - 1) { pg8::StdProb P(WSP(OFF_R1), WSP(OFF_WB) + (size_t)HID * DM, 64, 64, HID, 0, 0, 128, 4, 1, G, c); P.skipctx = true; P.ksA = (size_t)MTOK * 128; P.ksB = (size_t)DM * 128; pg8::gemm_phase(lds, P, E); }
            else { pg8::TailProb<4> P(WSP(OFF_R1), WSP(OFF_WB) + (size_t)HID * DM, 64, HID, G, c, G == 256); P.ksA = (size_t)MTOK * 128; P.ksB = (size_t)DM * 128; P.sliceA = (size_t)16 * MTOK * 64; P.sliceB = (size_t)16 * DM * 64;
                   pg8::gemm_phase(lds, P, E); }
        } PH_END
#endif
    }
    { const int lv = 0; PH_BEGIN final_norm(a); PH_END }
}

extern "C" void kernel_launch(void* const* d_in, const int* in_sizes, int n_in, void* d_out, int out_size, void* d_ws, size_t ws_size, hipStream_t stream) {
    static int grid = 0;
    if (grid == 0) {
        if (n_in != 27 || ws_size < WS_END) { fprintf(stderr, "kernel_launch: unexpected n_in %d or ws_size %zu (need %zu)\n", n_in, ws_size, (size_t)WS_END); grid = -1; return; }
        if (hipFuncSetAttribute((const void*)mega, hipFuncAttributeMaxDynamicSharedMemorySize, LDS_BYTES) != hipSuccess) { fprintf(stderr, "kernel_launch: hipFuncSetAttribute failed\n"); grid = -1; return; }
        int dev = 0, cus = 0, per_cu = 0;
        hipGetDevice(&dev); hipDeviceGetAttribute(&cus, hipDeviceAttributeMultiprocessorCount, dev);
        hipOccupancyMaxActiveBlocksPerMultiprocessor(&per_cu, (const void*)mega, 512, LDS_BYTES);
        if (per_cu < 1) { fprintf(stderr, "kernel_launch: occupancy query gives %d\n", per_cu); per_cu = 1; }
        grid = cus;
        (void)hipGetLastError();
    }
    if (grid < 0) return;
    if (hipMemsetAsync((char*)d_ws + OFF_BAR, 0, XCD_BAR_WORDS * 4, stream) != hipSuccess) { fprintf(stderr, "kernel_launch: memset failed\n"); return; }
    Args a{};
    const float** ap = (const float**)&a;
    for (int i = 0; i < 27; ++i) ap[i] = (const float*)d_in[i];
    a.out = (float*)d_out; a.ws = (unsigned char*)d_ws;
#if ONE_LAUNCH
    a.ph_lo = 0; a.ph_hi = NPHASE;
    void* args[] = {&a};
    hipError_t e = hipLaunchCooperativeKernel((const void*)mega, dim3(grid), dim3(512), args, LDS_BYTES, stream);
    if (e != hipSuccess) fprintf(stderr, "cooperative launch failed: %s (grid %d)\n", hipGetErrorString(e), grid);
#else
    for (int p = 0; p < NPHASE; ++p) { a.ph_lo = p; a.ph_hi = p + 1; hipLaunchKernelGGL(mega, dim3(grid), dim3(512), LDS_BYTES, stream, a); }
#endif
}
```

```cpp
#include <hip/hip_runtime.h>
#include <hip/hip_cooperative_groups.h>
#include <cstdio>
#include <cstdint>
namespace cg = cooperative_groups;

#ifndef ONE_LAUNCH
#define ONE_LAUNCH 1
#endif
#ifndef GEMM_SP2
#define GEMM_SP2 1
#endif

#define LAS __attribute__((address_space(3)))
typedef unsigned short bf16_t;
typedef short bf16x8 __attribute__((ext_vector_type(8)));
typedef float f32x4 __attribute__((ext_vector_type(4)));
typedef float f32x2 __attribute__((ext_vector_type(2)));
typedef unsigned u32x4 __attribute__((ext_vector_type(4)));
typedef unsigned u32x2 __attribute__((ext_vector_type(2)));
typedef float f32x16 __attribute__((ext_vector_type(16)));

constexpr int DM = 1024, NB = 8, SEQ = 4096, CTXL = 256, TPB = 4352  , MTOK = NB * TPB  , DEPTH = 4;
constexpr int INW = 6656, HID = 4096;
constexpr int TCH = 32  , CPB = TPB / TCH  , NCR = NB * CPB  ;
constexpr int NPHASE = 1 + DEPTH * 10 + 1;

constexpr size_t OFF_XC = 0;
constexpr size_t OFF_MODS = OFF_XC + 8388608;
constexpr size_t OFF_AP = OFF_MODS + 884736;
constexpr size_t OFF_BB = OFF_AP + 4325376;
constexpr size_t OFF_KTAB = OFF_BB + 2097152;
constexpr size_t OFF_WA = OFF_KTAB + 2097152;
constexpr size_t WA_WIN = 0, WA_CONV = 13631488, WA_GLUA = WA_CONV + 1048576, WA_GLUB = WA_GLUA + 1048576, WA_NA = WA_GLUB + 1048576, WA_WOUT = WA_NA + 1048576, WA_SIZE = WA_WOUT + 2097152;
constexpr size_t OFF_WB = OFF_WA + WA_SIZE;
constexpr size_t OFF_HN = OFF_WB + 16777216;
constexpr size_t OFF_A2 = OFF_HN + 71303168;
constexpr size_t OFF_BTY = OFF_A2 + 53477376;
constexpr size_t OFF_WET = OFF_BTY + 25165824;
constexpr size_t OFF_R1 = OFF_WET + 8388608;
constexpr size_t OFF_R2 = OFF_R1 + 213909504;
constexpr size_t SZ_ACT = 35651584;
constexpr int PALD = 2048;
constexpr size_t OFF_KH = OFF_R1 + (size_t)MTOK * PALD * 2;
constexpr size_t OFF_VT = OFF_KH + SZ_ACT;
constexpr size_t WS_END = OFF_R2 + 3 * SZ_ACT;
static_assert(WS_END + 16384 <= 541000000, "workspace");

constexpr size_t OFF_BAR = WS_END;
constexpr int LDS_BYTES = 147712 + 16;

struct Args {
    const float *x, *c, *ctx, *c_ctx, *w_mod, *b_mod, *norm1_g, *w_in, *conv_w, *conv_out, *lam_re, *lam_im, *log_step, *b_re, *b_im, *c_re, *c_im, *s5_d, *glu_a, *glu_b,
        *na_rpb, *na_out, *w_out, *norm2_g, *mlp_w1, *mlp_w2, *final_g;
    float* out; unsigned char* ws; int ph_lo, ph_hi;
};

typedef const Args __attribute__((address_space(4))) KArgs;

__device__ __forceinline__ int tid_() { int t = threadIdx.x; asm volatile("" : "+v"(t)); return t; }
__device__ __forceinline__ int bid_() { int t = blockIdx.x; asm volatile("" : "+s"(t)); return t; }
__device__ __forceinline__ int nblk_() { int t = gridDim.x; asm volatile("" : "+s"(t)); return t; }
__device__ __forceinline__ float bf2f(unsigned b) { return __uint_as_float(b << 16); }
typedef __bf16 bf16v2_t __attribute__((ext_vector_type(2)));
__device__ __forceinline__ unsigned pk2(float lo, float hi) { const f32x2 v = {lo, hi}; return __builtin_bit_cast(unsigned, __builtin_convertvector(v, bf16v2_t)); }
__device__ __forceinline__ float sigmoidf_(float x) { return __builtin_amdgcn_rcpf(1.f + __builtin_amdgcn_exp2f(-1.44269504f * x)); }
__device__ __forceinline__ float gelu_tanh(float x) { const float z = 0.7978845608f * (x + 0.044715f * x * x * x); return x * (1.f - __builtin_amdgcn_rcpf(1.f + __builtin_amdgcn_exp2f(2.88539008f * z))); }
__device__ __forceinline__ void unpack8(const u32x4 v, float (&f)[8]) {
    f[0] = __uint_as_float(v.x << 16); f[1] = __uint_as_float(v.x & 0xffff0000u); f[2] = __uint_as_float(v.y << 16); f[3] = __uint_as_float(v.y & 0xffff0000u);
    f[4] = __uint_as_float(v.z << 16); f[5] = __uint_as_float(v.z & 0xffff0000u); f[6] = __uint_as_float(v.w << 16); f[7] = __uint_as_float(v.w & 0xffff0000u);
}
__device__ __forceinline__ float wave_sum(float v) {
#pragma unroll
    for (int o = 1; o < 64; o <<= 1) v += __shfl_xor(v, o);
    return v;
}
__device__ __forceinline__ float* xrow(KArgs& a, int r) {
    const int b = r / TPB, t = r - b * TPB;
    return t < CTXL ? (float*)(a.ws + OFF_XC) + ((size_t)b * CTXL + t) * DM : a.out + ((size_t)b * SEQ + (t - CTXL)) * DM;
}

#define XB_TMO      128
#define XB_XCNT(j)  (256  + 64 * (j))
#define XB_XSUB(j)  (1280 + 64 * (j))
#define XB_XGEN(j)  (2304 + 64 * (j))
#define XB_TOP      3328
#define XB_TOPGEN   3392
#define XCD_BAR_WORDS 3456
#define XB_SPIN_CAP (1u << 18)

__device__ __forceinline__ unsigned xb_ld(unsigned* p)              { return __hip_atomic_load(p, __ATOMIC_RELAXED, __HIP_MEMORY_SCOPE_AGENT); }
__device__ __forceinline__ unsigned xb_add(unsigned* p, unsigned v) { return __hip_atomic_fetch_add(p, v, __ATOMIC_RELAXED, __HIP_MEMORY_SCOPE_AGENT); }
__device__ __forceinline__ unsigned xb_xcc_id() { return (unsigned)__builtin_amdgcn_s_getreg((3 << 11) | 20) & 0xFu; }
#define XB_SPIN(cond, bar) do { unsigned _sp = 0; while (cond) { __builtin_amdgcn_s_sleep(1); \
    if ((++_sp & 255u) == 0u) { if (xb_ld(&(bar)[XB_TMO])) break; if (_sp > XB_SPIN_CAP) { atomicAdd(&(bar)[XB_TMO], 1u); break; } } } } while (0)

struct XcdBarrier {
    unsigned* bar; unsigned x;
    volatile LAS unsigned* st;
};

__device__ __forceinline__ XcdBarrier xcd_barrier_post(unsigned* bar, volatile LAS unsigned* st) {
    XcdBarrier b; b.bar = bar; b.x = xb_xcc_id(); b.st = st;
    if (threadIdx.x == 0) (void)xb_add(&bar[XB_XCNT(b.x)], 1u);
    return b;
}
__device__ __forceinline__ void xcd_barrier_complete(unsigned* bar, unsigned x, unsigned& nloc, unsigned& nx) {
    const unsigned G = gridDim.x * gridDim.y * gridDim.z;
    unsigned sum, cnt, mine, sp = 0u;
    for (;;) {
        sum = 0u; cnt = 0u; mine = 0u;
#pragma unroll
        for (unsigned j = 0; j < 16; ++j) { const unsigned c = xb_ld(&bar[XB_XCNT(j)]); sum += c; cnt += (c > 0u) ? 1u : 0u; mine = (j == x) ? c : mine; }
        if (sum == G) break;
        __builtin_amdgcn_s_sleep(1);
        if ((++sp & 255u) == 0u) { if (xb_ld(&bar[XB_TMO])) break; if (sp > XB_SPIN_CAP) { atomicAdd(&bar[XB_TMO], 1u); break; } }
    }
    nloc = mine > 0u ? mine : 1u; nx = cnt > 0u ? cnt : 1u;
}

__device__ __forceinline__ void xcd_barrier(const XcdBarrier& b) {
    asm volatile("s_waitcnt vmcnt(0)" ::: "memory");
    __syncthreads();
    if (threadIdx.x == 0) {
        unsigned* bar = b.bar;
        __builtin_amdgcn_s_waitcnt(0);
        unsigned nloc = b.st[0], nx = b.st[1];
        if (nloc == 0u) { xcd_barrier_complete(bar, b.x, nloc, nx); b.st[0] = nloc; b.st[1] = nx; }
        const unsigned old = xb_add(&bar[XB_XSUB(b.x)], 1u);
        const unsigned gen = old / nloc;
        if (old + 1u == (gen + 1u) * nloc) {
            __builtin_amdgcn_fence(__ATOMIC_RELEASE, "agent");
            asm volatile("s_waitcnt vmcnt(0)" ::: "memory");
            const unsigned og = xb_add(&bar[XB_TOP], 1u);
            const unsigned tg = og / nx;
            if (og + 1u == (tg + 1u) * nx) xb_add(&bar[XB_TOPGEN], 1u);
            else XB_SPIN(xb_ld(&bar[XB_TOPGEN]) == tg, bar);
            __builtin_amdgcn_fence(__ATOMIC_ACQUIRE, "agent");
            xb_add(&bar[XB_XGEN(b.x)], 1u);
            asm volatile("s_waitcnt vmcnt(0)" ::: "memory");
        } else {
            XB_SPIN(xb_ld(&bar[XB_XGEN(b.x)]) == gen, bar);
            __builtin_amdgcn_fence(__ATOMIC_ACQUIRE, "agent");
            asm volatile("s_waitcnt vmcnt(0)" ::: "memory");
        }
    }
    __syncthreads();
}


namespace pg8 {
constexpr int BM = 256, BK = 64, HALF = 128, HTB = HALF * BK * 2, STAGE_BYTES = 8 * HTB, NXCD = 8, WGM = 8;
__device__ __forceinline__ int lds_byte(int r, int c) { const int st = (r >> 4) * 2 + (c >> 5), rr = r & 15, cc = c & 31, ob = rr * 64 + cc * 2; return st * 1024 + (ob ^ (((ob >> 9) & 1) << 5)); }
__device__ __forceinline__ int perm32(int rho) { const int n = rho >> 4, i = rho & 15; return 8 * (i >> 2) + 4 * n + (i & 3); }
__device__ __forceinline__ void stage_rc(int b, int& R, int& C) { const int st = b / 1024, sb = b % 1024, swz = sb ^ (((sb >> 9) & 1) << 5); R = (st >> 1) * 16 + swz / 64; C = (st & 1) * 32 + (swz % 64) / 2; }

struct Unit { int batch, pm, pn, aux; };
__device__ __forceinline__ void std_map(int wgid, int nM, int nN, int& pm, int& pn) {
    const int nwg = nM * nN;
    { const int q = nwg / NXCD, r = nwg % NXCD, xcd = wgid % NXCD, off = wgid / NXCD; wgid = (xcd < r ? xcd * (q + 1) : r * (q + 1) + (xcd - r) * q) + off; }
    const int nig = WGM * nN, gid = wgid / nig, fm = gid * WGM, gsz = (nM - fm) < WGM ? (nM - fm) : WGM;
    pm = fm + ((wgid % nig) % gsz); pn = (wgid % nig) / gsz;
}
struct StdProb {
    size_t ksA = 128, ksB = 128;
    const bf16_t* A; const bf16_t* Bt; int lda, ldb, K; size_t strideA, strideB; int nM, nN, nwg, total, G, c;
    __device__ __forceinline__ StdProb(const bf16_t* A_, const bf16_t* Bt_, int lda_, int ldb_, int K_, size_t sA, size_t sB, int nM_, int nN_, int nbatch, int G_, int c_)
        : A(A_), Bt(Bt_), lda(lda_), ldb(ldb_), K(K_), strideA(sA), strideB(sB), nM(nM_), nN(nN_), nwg(nM_ * nN_), total(nM_ * nN_ * nbatch), G(G_), c(c_) {}
    bool skipctx = false;
    __device__ __forceinline__ bool next(int i, Unit& u) const {
        const int L = i * G + c; if (L >= total) return false;
        u.batch = L / nwg; std_map(L - u.batch * nwg, nM, nN, u.pm, u.pn); if (skipctx) u.pm += (u.pm >> 4) + 1; return true;
    }
    __device__ __forceinline__ int ktiles(const Unit&) const { return K / BK; }
    __device__ __forceinline__ size_t kstepA() const { return ksA; }
    __device__ __forceinline__ size_t kstepB() const { return ksB; }
    __device__ __forceinline__ bool full(const Unit&) const { return true; }
    __device__ __forceinline__ long bhalf(const Unit&) const { return (long)HALF * ldb * 2; }
    __device__ __forceinline__ const char* abase(const Unit& u) const { return (const char*)(A + (size_t)u.batch * strideA + (size_t)u.pm * 256 * lda); }
    __device__ __forceinline__ const char* bbase(const Unit& u) const { return (const char*)(Bt + (size_t)u.batch * strideB + (size_t)u.pn * 256 * ldb); }
};
struct In1Prob {
    const bf16_t* HN; const bf16_t* W; int lda, ldb, K, G, c;
    __device__ __forceinline__ bool next(int i, Unit& u) const {
        const int L = i * G + c; if (L >= 1632 + 272) return false;
        if (L < 1632) { u.batch = 0; std_map(L, 136, 12, u.pm, u.pn); } else { const int j = L - 1632; u.batch = 1; u.pm = j & 1; u.pn = j >> 1; }
        return true;
    }
    __device__ __forceinline__ int ktiles(const Unit&) const { return K / BK; }
    __device__ __forceinline__ size_t kstepA() const { return 128; }
    __device__ __forceinline__ size_t kstepB() const { return 128; }
    __device__ __forceinline__ bool full(const Unit&) const { return true; }
    __device__ __forceinline__ long bhalf(const Unit&) const { return (long)HALF * ldb * 2; }
    __device__ __forceinline__ const char* abase(const Unit& u) const { return (const char*)(u.batch == 0 ? HN + (size_t)u.pm * 256 * DM : W + (size_t)(3072 + u.pm * 256) * DM); }
    __device__ __forceinline__ const char* bbase(const Unit& u) const { return (const char*)(u.batch == 0 ? W + (size_t)u.pn * 256 * DM : HN + (size_t)u.pn * 256 * DM); }
};
struct MergeProb {
    const bf16_t* GS5; const bf16_t* ACV; const bf16_t* OAT; const bf16_t* WA; int lda, ldb, K, G, c, nM;
    __device__ __forceinline__ bool next(int i, Unit& u) const {
        const int U = (i >> 2) * G + c; if (U >= nM * 4) return false;
        u.batch = i & 3; std_map(U, nM, 4, u.pm, u.pn); if (nM == 128) u.pm += (u.pm >> 4) + 1; return true;
    }
    __device__ __forceinline__ int ktiles(const Unit&) const { return 8; }
    __device__ __forceinline__ size_t kstepA() const { return 128; }
    __device__ __forceinline__ size_t kstepB() const { return 128; }
    __device__ __forceinline__ bool full(const Unit&) const { return true; }
    __device__ __forceinline__ long bhalf(const Unit&) const { return (long)HALF * ldb * 2; }
    __device__ __forceinline__ const char* abase(const Unit& u) const { const int sl = (u.batch & 2) ? ((u.batch & 1) << 1) : 1; return (const char*)(ACV + (size_t)sl * (SZ_ACT / 2) + (size_t)u.pm * 256 * 512); }
    __device__ __forceinline__ const char* bbase(const Unit& u) const { const int t = (u.batch + 1) >> 2, sl = t * 3 + (1 - t) * (2 - u.batch); return (const char*)(WA + WA_CONV / 2 + (size_t)sl * 524288 + (size_t)u.pn * 256 * 512); }
};
struct CPProb {
    const bf16_t* ACV; const bf16_t* WA; int lda, ldb, K, G, c, nM;
    __device__ __forceinline__ bool next(int i, Unit& u) const {
        const int su = i / 3, U = su * G + c; if (U >= nM * 8) return false;
        u.batch = i - 3 * su; u.aux = 0; std_map(U, nM, 8, u.pm, u.pn); if (nM == 128) u.pm += (u.pm >> 4) + 1; return true;
    }
    __device__ __forceinline__ int ktiles(const Unit&) const { return 8; }
    __device__ __forceinline__ size_t kstepA() const { return 128; }
    __device__ __forceinline__ size_t kstepB() const { return 128; }
    __device__ __forceinline__ bool full(const Unit& u) const { return u.batch == 0; }
    __device__ __forceinline__ long bhalf(const Unit& u) const { return u.batch == 0 ? (long)WA_GLUA - (long)WA_GLUB : 0L; }
    __device__ __forceinline__ const char* abase(const Unit& u) const { const int sl = 1 - u.batch + 3 * (u.batch >> 1); return (const char*)(ACV + (size_t)sl * (SZ_ACT / 2) + (size_t)u.pm * 256 * 512); }
    __device__ __forceinline__ const char* bbase(const Unit& u) const { const int sl = 2 * (u.batch == 0 ? 1 : 0) + 3 * (u.batch >> 1); return (const char*)(WA + WA_CONV / 2 + (size_t)sl * 524288 + (size_t)u.pn * 128 * 512); }
};
struct HalfMergeProb {
    const bf16_t* ACV; const bf16_t* WA; int lda, ldb, K, G, c, nM2;
    __device__ __forceinline__ bool next(int i, Unit& u) const {
        const int U = (i >> 2) * G + c; if (U >= nM2 * 4) return false;
        u.batch = i & 3; u.aux = 0; std_map(U, nM2, 4, u.pm, u.pn); if (nM2 == 256) u.pm += 2 * (u.pm >> 5) + 2; return true;
    }
    __device__ __forceinline__ int ktiles(const Unit&) const { return 8; }
    __device__ __forceinline__ size_t kstepA() const { return 128; }
    __device__ __forceinline__ size_t kstepB() const { return 128; }
    __device__ __forceinline__ bool full(const Unit&) const { return true; }
    __device__ __forceinline__ long bhalf(const Unit&) const { return (long)HALF * ldb * 2; }
    __device__ __forceinline__ const char* abase(const Unit& u) const { const int sl = (u.batch & 2) ? ((u.batch & 1) << 1) : 1; return (const char*)(ACV + (size_t)sl * (SZ_ACT / 2) + (size_t)u.pm * 128 * 512); }
    __device__ __forceinline__ const char* bbase(const Unit& u) const { const int t = (u.batch + 1) >> 2, sl = t * 3 + (1 - t) * (2 - u.batch); return (const char*)(WA + WA_CONV / 2 + (size_t)sl * 524288 + (size_t)u.pn * 256 * 512); }
};
template <int NS> struct TailProb {
    size_t ksA = 128, ksB = 128; size_t sliceA = 0, sliceB = 0;
    const bf16_t* A; const bf16_t* Bt; int lda, ldb, K, G, c, nunits, nfull;
    __device__ __forceinline__ TailProb(const bf16_t* A_, const bf16_t* Bt_, int ld, int K_, int G_, int c_, bool split) : A(A_), Bt(Bt_), lda(ld), ldb(ld), K(K_), G(G_), c(c_) { nunits = 544; nfull = split ? 512 : 544; }
    __device__ __forceinline__ bool next(int i, Unit& u) const {
        const int L = i * G + c; const int ntail = nunits - nfull;
        if (L < nfull) { u.batch = 0; u.aux = 0; std_map(L, 136, 4, u.pm, u.pn); return true; }
        const int j = L - nfull; if (j >= ntail * NS) return false;
        u.batch = 1 + j / ntail; u.aux = j % ntail; std_map(nfull + u.aux, 136, 4, u.pm, u.pn); return true;
    }
    __device__ __forceinline__ int ktiles(const Unit& u) const { return u.batch == 0 ? K / BK : K / (BK * NS); }
    __device__ __forceinline__ size_t kstepA() const { return ksA; }
    __device__ __forceinline__ size_t kstepB() const { return ksB; }
    __device__ __forceinline__ bool full(const Unit&) const { return true; }
    __device__ __forceinline__ long bhalf(const Unit&) const { return (long)HALF * ldb * 2; }
    __device__ __forceinline__ const char* abase(const Unit& u) const { return (const char*)(A + (size_t)u.pm * 256 * lda + (u.batch == 0 ? (size_t)0 : (size_t)(u.batch - 1) * (sliceA ? sliceA : (size_t)(K / NS)))); }
    __device__ __forceinline__ const char* bbase(const Unit& u) const { return (const char*)(Bt + (size_t)u.pn * 256 * ldb + (u.batch == 0 ? (size_t)0 : (size_t)(u.batch - 1) * (sliceB ? sliceB : (size_t)(K / NS)))); }
};
template <class F> __device__ __forceinline__ void epi_foreach(const f32x4 (&acc)[2][2][4][2], int wr, int wc, int fr, int fq, F f) {
#pragma unroll
    for (int ai = 0; ai < 2; ++ai)
#pragma unroll
        for (int m = 0; m < 4; ++m)
#pragma unroll
            for (int bj = 0; bj < 2; ++bj)
#pragma unroll
                for (int n = 0; n < 2; ++n) f(ai * HALF + wr * 64 + m * 16 + fr, bj * HALF + wc * 32 + n * 16 + 4 * fq, acc[ai][bj][m][n]);
}

template <class F> __device__ __forceinline__ void epi_foreach8(const f32x4 (&acc)[2][2][4][2], int wr, int wc, int fr, int fq, F f) {
#pragma unroll
    for (int ai = 0; ai < 2; ++ai)
#pragma unroll
        for (int m = 0; m < 4; ++m)
#pragma unroll
            for (int bj = 0; bj < 2; ++bj) f(ai * HALF + wr * 64 + m * 16 + fr, bj * HALF + wc * 32 + 8 * fq, acc[ai][bj][m][0], acc[ai][bj][m][1]);
}
template <bool HM = false, bool PERM = false, bool CP = false, class Prob, class Epi>
__device__ __forceinline__ void gemm_phase(LAS unsigned char* lds, const Prob& S, const Epi& E) {
    int tid = threadIdx.x; asm volatile("" : "+v"(tid));
    const int wid = __builtin_amdgcn_readfirstlane(tid >> 6), lane = tid & 63, wr = wid >> 2, wc = wid & 3, fr = lane & 15, fq = lane >> 4;
    unsigned voffA[2], voffB[2];
#pragma unroll
    for (int i = 0; i < 2; ++i) { int R, C; stage_rc(tid * 16 + i * 8192, R, C); const int Rb = PERM ? ((R & ~31) + perm32(R & 31)) : R; voffA[i] = (unsigned)(R * S.lda + C) * 2u; voffB[i] = (unsigned)(Rb * S.ldb + C) * 2u; }
    const size_t kstepA = S.kstepA(), kstepB = S.kstepB();
    const size_t hstepA = HM ? 0 : (size_t)HALF * S.lda * 2; const long hstepB0 = (long)HALF * S.ldb * 2;
    const unsigned ldsw = (unsigned)wid * 1024u;
    const int aoff = lds_byte(wr * 64 + fr, fq * 8), boff = lds_byte(wc * 32 + fr, fq * 8);
#define PG8_SA(b, h) (((b) * 2 + (h)) * HTB)
#define PG8_SB(b, h) ((4 + (b) * 2 + (h)) * HTB)
#define PG8_STAGE(bufoff, gbase, voff) do { _Pragma("unroll") for (int _i = 0; _i < 2; ++_i) \
        __builtin_amdgcn_global_load_lds((const unsigned*)((const char*)(gbase) + (voff)[_i]), (LAS unsigned*)(lds + (bufoff) + ldsw + _i * 8192), 16, 0, 0); } while (0)
#define PG8_LDA(dst, b, h) do { _Pragma("unroll") for (int m = 0; m < 4; ++m) _Pragma("unroll") for (int k = 0; k < 2; ++k) dst[m][k] = *(const LAS bf16x8*)(lds + PG8_SA(b, h) + aoff + m * 2048 + k * 1024); } while (0)
#define PG8_LDB(dst, b, h) do { _Pragma("unroll") for (int n = 0; n < 2; ++n) _Pragma("unroll") for (int k = 0; k < 2; ++k) dst[n][k] = *(const LAS bf16x8*)(lds + PG8_SB(b, h) + boff + n * 2048 + k * 1024); } while (0)
#define PG8_MMA(ai, bj, At, Bt) do { __builtin_amdgcn_s_setprio(1); _Pragma("unroll") for (int m = 0; m < 4; ++m) _Pragma("unroll") for (int n = 0; n < 2; ++n) _Pragma("unroll") for (int k = 0; k < 2; ++k) \
        acc[ai][bj][m][n] = __builtin_amdgcn_mfma_f32_16x16x32_bf16(Bt[n][k], At[m][k], acc[ai][bj][m][n], 0, 0, 0); __builtin_amdgcn_s_setprio(0); } while (0)
#define PG8_WAIT_V(n) asm volatile("s_waitcnt vmcnt(" #n ")" ::: "memory")
#define PG8_WAIT_L(n) asm volatile("s_waitcnt lgkmcnt(" #n ")" ::: "memory")
#define PG8_BAR __builtin_amdgcn_s_barrier()
#define PG8_SCHED __builtin_amdgcn_sched_barrier(0)
    Unit cur, nxt; int ui = 0;
    if (!S.next(0, cur)) return;
    f32x4 acc[2][2][4][2];
#pragma unroll
    for (int a = 0; a < 2; ++a)
#pragma unroll
        for (int b = 0; b < 2; ++b)
#pragma unroll
            for (int m = 0; m < 4; ++m)
#pragma unroll
                for (int n = 0; n < 2; ++n) acc[a][b][m][n] = (f32x4){0.f, 0.f, 0.f, 0.f};
    bf16x8 At[4][2], B0[2][2], B1[2][2];
    const char* cA = S.abase(cur);
    const char* cB = S.bbase(cur);
    long chB = CP ? S.bhalf(cur) : hstepB0; bool fullu = CP ? S.full(cur) : true;
#if GEMM_SP2
    PG8_STAGE(PG8_SB(0, 0), cB, voffB); PG8_STAGE(PG8_SB(0, 1), cB + chB, voffB); PG8_STAGE(PG8_SA(0, 0), cA, voffA); PG8_STAGE(PG8_SA(0, 1), cA + hstepA, voffA);
    if (wr == 1) PG8_BAR;
    PG8_WAIT_V(2); PG8_BAR;
    PG8_STAGE(PG8_SB(1, 0), cB + kstepB, voffB); PG8_STAGE(PG8_SA(1, 0), cA + kstepA, voffA); PG8_STAGE(PG8_SB(1, 1), cB + chB + kstepB, voffB);
    PG8_WAIT_V(6); PG8_BAR;
#else
    PG8_STAGE(PG8_SB(0, 0), cB, voffB); PG8_STAGE(PG8_SA(0, 0), cA, voffA); PG8_STAGE(PG8_SB(0, 1), cB + chB, voffB); PG8_STAGE(PG8_SA(0, 1), cA + hstepA, voffA);
    if (wr == 1) PG8_BAR;
    PG8_WAIT_V(4); PG8_BAR;
    PG8_STAGE(PG8_SB(1, 0), cB + kstepB, voffB); PG8_STAGE(PG8_SA(1, 0), cA + kstepA, voffA); PG8_STAGE(PG8_SB(1, 1), cB + chB + kstepB, voffB);
    PG8_WAIT_V(6); PG8_BAR;
#endif
    for (;;) {
        const bool has_next = S.next(ui + 1, nxt);
        const char* nA = has_next ? S.abase(nxt) : cA;
        const char* nB = has_next ? S.bbase(nxt) : cB;
        const long nhB = (CP && has_next) ? S.bhalf(nxt) : chB;
        const int nt = S.ktiles(cur);
        for (int t = 0; t < nt; t += 2) {
            const bool last = (t == nt - 2);
            const char* a1 = cA + (size_t)(t + 1) * kstepA;
            const char* a2 = last ? nA : cA + (size_t)(t + 2) * kstepA; const char* b2 = last ? nB : cB + (size_t)(t + 2) * kstepB;
            const char* a3 = a2 + kstepA; const char* b3 = b2 + kstepB; const long h2 = last ? nhB : chB;
#if GEMM_SP2
            PG8_LDB(B0, 0, 0); PG8_LDB(B1, 0, 1); PG8_SCHED; PG8_LDA(At, 0, 0); PG8_STAGE(PG8_SA(1, 1), a1 + hstepA, voffA);
            PG8_WAIT_V(8); PG8_WAIT_L(0); PG8_BAR; if (!CP || fullu) PG8_MMA(0, 0, At, B0); PG8_MMA(0, 1, At, B1); PG8_BAR; PG8_SCHED;
            if (!HM) PG8_LDA(At, 0, 1); PG8_STAGE(PG8_SB(0, 0), b2, voffB); PG8_STAGE(PG8_SB(0, 1), b2 + h2, voffB); PG8_STAGE(PG8_SA(0, 0), a2, voffA);
            PG8_WAIT_V(8); PG8_WAIT_L(0); PG8_BAR; if (!HM) { if (!CP || fullu) PG8_MMA(1, 0, At, B0); PG8_MMA(1, 1, At, B1); } PG8_BAR; PG8_SCHED;
            PG8_LDB(B0, 1, 0); PG8_LDB(B1, 1, 1); PG8_SCHED; PG8_LDA(At, 1, 0); PG8_STAGE(PG8_SA(0, 1), a2 + hstepA, voffA);
            PG8_WAIT_V(8); PG8_WAIT_L(0); PG8_BAR; if (!CP || fullu) PG8_MMA(0, 0, At, B0); PG8_MMA(0, 1, At, B1); PG8_BAR; PG8_SCHED;
            if (!HM) PG8_LDA(At, 1, 1); PG8_STAGE(PG8_SB(1, 0), b3, voffB); PG8_STAGE(PG8_SB(1, 1), b3 + h2, voffB); PG8_STAGE(PG8_SA(1, 0), a3, voffA);
            PG8_WAIT_V(8); PG8_WAIT_L(0); PG8_BAR; if (!HM) { if (!CP || fullu) PG8_MMA(1, 0, At, B0); PG8_MMA(1, 1, At, B1); } PG8_BAR; PG8_SCHED;
#else
            PG8_LDB(B0, 0, 0); PG8_SCHED; PG8_LDA(At, 0, 0); PG8_STAGE(PG8_SA(1, 1), a1 + hstepA, voffA);
            PG8_WAIT_L(8); PG8_BAR; PG8_WAIT_L(0); PG8_MMA(0, 0, At, B0); PG8_BAR; PG8_SCHED;
            PG8_LDB(B1, 0, 1); PG8_STAGE(PG8_SB(0, 0), b2, voffB);
            PG8_BAR; PG8_WAIT_L(0); PG8_MMA(0, 1, At, B1); PG8_BAR;
            if (!HM) PG8_LDA(At, 0, 1); PG8_STAGE(PG8_SA(0, 0), a2, voffA);
            PG8_BAR; PG8_WAIT_L(0); if (!HM) PG8_MMA(1, 0, At, B0); PG8_BAR; PG8_SCHED;
            PG8_STAGE(PG8_SB(0, 1), b2 + h2, voffB);
            PG8_WAIT_V(6); PG8_BAR; if (!HM) PG8_MMA(1, 1, At, B1); PG8_BAR;
            PG8_LDB(B0, 1, 0); PG8_SCHED; PG8_LDA(At, 1, 0); PG8_STAGE(PG8_SA(0, 1), a2 + hstepA, voffA);
            PG8_WAIT_L(8); PG8_BAR; PG8_WAIT_L(0); PG8_MMA(0, 0, At, B0); PG8_BAR; PG8_SCHED;
            PG8_LDB(B1, 1, 1); PG8_STAGE(PG8_SB(1, 0), b3, voffB);
            PG8_BAR; PG8_WAIT_L(0); PG8_MMA(0, 1, At, B1); PG8_BAR;
            if (!HM) PG8_LDA(At, 1, 1); PG8_STAGE(PG8_SA(1, 0), a3, voffA);
            PG8_BAR; PG8_WAIT_L(0); if (!HM) PG8_MMA(1, 0, At, B0); PG8_BAR; PG8_SCHED;
            PG8_STAGE(PG8_SB(1, 1), b3 + h2, voffB);
            PG8_WAIT_V(6); PG8_BAR; if (!HM) PG8_MMA(1, 1, At, B1); PG8_BAR;
#endif
        }
        if (wr == 0) PG8_BAR;
        { int fr2 = fr, fq2 = fq; asm volatile("" : "+v"(fr2), "+v"(fq2)); E(acc, cur, wr, wc, fr2, fq2); }
        if (!has_next) break;
        if (CP) {
            const bool nf = S.full(nxt);
#pragma unroll
            for (int a = 0; a < 2; ++a)
#pragma unroll
                for (int m = 0; m < 4; ++m)
#pragma unroll
                    for (int n = 0; n < 2; ++n) { acc[a][1][m][n] = (f32x4){0.f, 0.f, 0.f, 0.f}; if (nf) acc[a][0][m][n] = (f32x4){0.f, 0.f, 0.f, 0.f}; }
            fullu = nf; chB = nhB;
        } else {
#pragma unroll
        for (int a = 0; a < (HM ? 1 : 2); ++a)
#pragma unroll
            for (int b = 0; b < 2; ++b)
#pragma unroll
                for (int m = 0; m < 4; ++m)
#pragma unroll
                    for (int n = 0; n < 2; ++n) acc[a][b][m][n] = (f32x4){0.f, 0.f, 0.f, 0.f};
        }
        cur = nxt; cA = nA; cB = nB; ++ui;
        if (wr == 1) PG8_BAR;
    }
    PG8_WAIT_V(0);
    PG8_BAR;
#undef PG8_SA
#undef PG8_SB
#undef PG8_STAGE
#undef PG8_LDA
#undef PG8_LDB
#undef PG8_MMA
#undef PG8_WAIT_V
#undef PG8_WAIT_L
#undef PG8_BAR
#undef PG8_SCHED
}
}
using pg8::Unit;

struct TileRows { int b, tb; __device__ __forceinline__ TileRows(int pm) { b = pm / 17; tb = pm - 17 * b; } };

struct EpiIn1 {
    bf16_t* PA; bf16_t* A2; bf16_t* VT;
    __device__ __forceinline__ void operator()(const f32x4 (&acc)[2][2][4][2], const Unit& u, int wr, int wc, int fr, int fq) const {
        const int row0 = u.pm * 256, col0 = u.pn * 256;
        if (u.batch == 1) {
            const int b = u.pn / 17, t0 = (u.pn - 17 * b) * 256;
            pg8::epi_foreach(acc, wr, wc, fr, fq, [&](int rl, int cl, const f32x4& v) {
                u32x2 o; o.x = pk2(v[0], v[1]); o.y = pk2(v[2], v[3]);
                *(u32x2*)(VT + ((size_t)b * 512 + row0 + rl) * TPB + t0 + cl) = o; });
        } else if (u.pn == 6 || u.pn == 7) {
            const TileRows tr(u.pm);
            pg8::epi_foreach(acc, wr, wc, fr, fq, [&](int rl, int cl, const f32x4& v) {
                const int t = tr.tb * 256 + rl, cr = tr.b * CPB + (t >> 5), s = t & 31, j = col0 - 1536 + cl, gidx = j >> 4, mm = j & 15;
                u32x2 o; o.x = pk2(v[0], v[1]); o.y = pk2(v[2], v[3]);
                *(u32x2*)(A2 + ((size_t)gidx * NCR + cr) * 768 + s * 16 + mm) = o; });
        } else {
            const int cdst = col0 - (u.pn >= 8 ? 512 : 0);
            pg8::epi_foreach(acc, wr, wc, fr, fq, [&](int rl, int cl, const f32x4& v) {
                u32x2 o; o.x = pk2(v[0], v[1]); o.y = pk2(v[2], v[3]);
                *(u32x2*)(PA + (size_t)(row0 + rl) * PALD + cdst + cl) = o; });
        }
    }
};
struct EpiIn1P {
    bf16_t* PA; bf16_t* A2; bf16_t* VT; bf16_t* KH;
    __device__ __forceinline__ void operator()(const f32x4 (&acc)[2][2][4][2], const Unit& u, int wr, int wc, int fr, int fq) const {
        const int row0 = u.pm * 256, col0 = u.pn * 256;
        if (u.batch == 1) {
            const int b = u.pn / 17, t0 = (u.pn - 17 * b) * 256;
            pg8::epi_foreach8(acc, wr, wc, fr, fq, [&](int rl, int cl, const f32x4& v0, const f32x4& v1) {
                const int f = row0 + rl, hh = f >> 6, dim = f & 63, t = t0 + cl;
                u32x4 o; o.x = pk2(v0[0], v0[1]); o.y = pk2(v0[2], v0[3]); o.z = pk2(v1[0], v1[1]); o.w = pk2(v1[2], v1[3]); *(u32x4*)(VT + (((size_t)(b * 8 + hh) * 544 + (t >> 3)) * 64 + dim) * 8) = o; });
        } else if (u.pn == 6 || u.pn == 7) {
            const TileRows tr(u.pm);
            pg8::epi_foreach8(acc, wr, wc, fr, fq, [&](int rl, int cl, const f32x4& v0, const f32x4& v1) {
                const int t = tr.tb * 256 + rl, cr = tr.b * CPB + (t >> 5), s = t & 31, j = col0 - 1536 + cl, gidx = j >> 4, mm = j & 15;
                u32x4 o; o.x = pk2(v0[0], v0[1]); o.y = pk2(v0[2], v0[3]); o.z = pk2(v1[0], v1[1]); o.w = pk2(v1[2], v1[3]); *(u32x4*)(A2 + ((size_t)gidx * NCR + cr) * 768 + s * 16 + mm) = o; });
        } else if (u.pn >= 10) {
            const TileRows tr(u.pm);
            pg8::epi_foreach8(acc, wr, wc, fr, fq, [&](int rl, int cl, const f32x4& v0, const f32x4& v1) {
                const int kc = col0 - 2560 + cl, hh = kc >> 6, dim = kc & 63, t = tr.tb * 256 + rl;
                u32x4 o; o.x = pk2(v0[0], v0[1]); o.y = pk2(v0[2], v0[3]); o.z = pk2(v1[0], v1[1]); o.w = pk2(v1[2], v1[3]); *(u32x4*)(KH + ((size_t)(tr.b * 8 + hh) * TPB + t) * 64 + dim) = o; });
        } else {
            const int cdst = col0 - (u.pn >= 8 ? 512 : 0);
            pg8::epi_foreach8(acc, wr, wc, fr, fq, [&](int rl, int cl, const f32x4& v0, const f32x4& v1) {
                u32x4 o; o.x = pk2(v0[0], v0[1]); o.y = pk2(v0[2], v0[3]); o.z = pk2(v1[0], v1[1]); o.w = pk2(v1[2], v1[3]); *(u32x4*)(PA + (size_t)(row0 + rl) * PALD + cdst + cl) = o; });
        }
    }
};
struct EpiYP {
    bf16_t* G;
    __device__ __forceinline__ void operator()(const f32x4 (&acc)[2][2][4][2], const Unit& u, int wr, int wc, int fr, int fq) const {
        pg8::epi_foreach8(acc, wr, wc, fr, fq, [&](int rl, int cl, const f32x4& a0, const f32x4& a1) {
            const int cr = u.pm * 256 + rl; if (cr < NCR) { const int b = cr / CPB, ch = cr - b * CPB, col = u.pn * 256 + cl, t = col >> 4, n = col & 15;
                const f32x4 v0 = {gelu_tanh(a0[0]), gelu_tanh(a0[1]), gelu_tanh(a0[2]), gelu_tanh(a0[3])}, v1 = {gelu_tanh(a1[0]), gelu_tanh(a1[1]), gelu_tanh(a1[2]), gelu_tanh(a1[3])};
                u32x4 o; o.x = pk2(v0[0], v0[1]); o.y = pk2(v0[2], v0[3]); o.z = pk2(v1[0], v1[1]); o.w = pk2(v1[2], v1[3]); *(u32x4*)(G + ((size_t)b * TPB + ch * TCH + t) * 512 + u.batch * 16 + n) = o; } });
    }
};
struct EpiGatesP {
    bf16_t* GT;
    __device__ __forceinline__ void operator()(const f32x4 (&acc)[2][2][4][2], const Unit& u, int wr, int wc, int fr, int fq) const {
        unsigned char* G8 = (unsigned char*)GT;
        pg8::epi_foreach8(acc, wr, wc, fr, fq, [&](int rl, int cl, const f32x4& a0, const f32x4& a1) {
            unsigned w0 = 0u, w1 = 0u;
#pragma unroll
            for (int i = 0; i < 4; ++i) { w0 |= (unsigned)(sigmoidf_(a0[i]) * 255.f + 0.5f) << (8 * i); w1 |= (unsigned)(sigmoidf_(a1[i]) * 255.f + 0.5f) << (8 * i); }
            const u32x2 o = {w0, w1};
            __builtin_nontemporal_store(o, (u32x2*)(G8 + (size_t)(u.pm * 256 + rl) * 3072 + u.pn * 256 + cl)); });
    }
};
struct EpiSqReluP {
    bf16_t* Hd;
    __device__ __forceinline__ void operator()(const f32x4 (&acc)[2][2][4][2], const Unit& u, int wr, int wc, int fr, int fq) const {
        pg8::epi_foreach8(acc, wr, wc, fr, fq, [&](int rl, int cl, const f32x4& a0, const f32x4& a1) {
            f32x4 v0, v1;
#pragma unroll
            for (int i = 0; i < 4; ++i) { const float r0 = fmaxf(a0[i], 0.f), r1 = fmaxf(a1[i], 0.f); v0[i] = r0 * r0; v1[i] = r1 * r1; }
            u32x4 o; o.x = pk2(v0[0], v0[1]); o.y = pk2(v0[2], v0[3]); o.z = pk2(v1[0], v1[1]); o.w = pk2(v1[2], v1[3]); const int cc = u.pn * 256 + cl; __builtin_nontemporal_store(o, (u32x4*)(Hd + ((size_t)(cc >> 6) * MTOK + (size_t)(u.pm * 256 + rl)) * 64 + (cc & 63))); });
    }
};
struct EpiE {
    float* E;
    __device__ __forceinline__ void operator()(const f32x4 (&acc)[2][2][4][2], const Unit& u, int wr, int wc, int fr, int fq) const {
        pg8::epi_foreach(acc, wr, wc, fr, fq, [&](int rl, int cl, const f32x4& v) {
            const int r = u.pm * 256 + rl; if (r < NCR) *(f32x4*)(E + ((size_t)u.batch * NCR + r) * 256 + cl) = v; });
    }
};
struct EpiY {
    bf16_t* G;
    __device__ __forceinline__ void operator()(const f32x4 (&acc)[2][2][4][2], const Unit& u, int wr, int wc, int fr, int fq) const {
        pg8::epi_foreach(acc, wr, wc, fr, fq, [&](int rl, int cl, const f32x4& v) {
            const int cr = u.pm * 256 + rl; if (cr < NCR) { const int b = cr / CPB, ch = cr - b * CPB, col = u.pn * 256 + cl, t = col >> 4, n = col & 15;
                u32x2 o; o.x = pk2(gelu_tanh(v[0]), gelu_tanh(v[1])); o.y = pk2(gelu_tanh(v[2]), gelu_tanh(v[3]));
                *(u32x2*)(G + ((size_t)b * TPB + ch * TCH + t) * 512 + u.batch * 16 + n) = o; } });
    }
};
struct EpiGates {
    bf16_t* GT;
    __device__ __forceinline__ void operator()(const f32x4 (&acc)[2][2][4][2], const Unit& u, int wr, int wc, int fr, int fq) const {
        pg8::epi_foreach(acc, wr, wc, fr, fq, [&](int rl, int cl, const f32x4& v) {
            u32x2 o; o.x = pk2(sigmoidf_(v[0]), sigmoidf_(v[1])); o.y = pk2(sigmoidf_(v[2]), sigmoidf_(v[3]));
            *(u32x2*)(GT + (size_t)(u.pm * 256 + rl) * 3072 + u.pn * 256 + cl) = o; });
    }
};
template <int MODE> struct EpiMerge {
    bf16_t* Mg; const bf16_t* GT;
    __device__ __forceinline__ void operator()(const f32x4 (&acc)[2][2][4][2], const Unit& u, int wr, int wc, int fr, int fq) const {
        pg8::epi_foreach(acc, wr, wc, fr, fq, [&](int rl, int cl, const f32x4& v) {
            const size_t r = (size_t)(u.pm * 256 + rl); const int c = u.pn * 256 + cl;
            u32x2* mp = (u32x2*)(Mg + r * DM + c);
            float gv[4] = {1.f, 1.f, 1.f, 1.f}, mv[4] = {0.f, 0.f, 0.f, 0.f};
            if (MODE != 1) { const u32x2 gq = *(const u32x2*)(GT + r * 3072 + (MODE == 0 ? 1024 : (MODE == 2 ? 0 : 2048)) + c);
                gv[0] = bf2f(gq.x & 0xffffu); gv[1] = __uint_as_float(gq.x & 0xffff0000u); gv[2] = bf2f(gq.y & 0xffffu); gv[3] = __uint_as_float(gq.y & 0xffff0000u); }
            if (MODE != 0) { const u32x2 mq = *mp;
                mv[0] = bf2f(mq.x & 0xffffu); mv[1] = __uint_as_float(mq.x & 0xffff0000u); mv[2] = bf2f(mq.y & 0xffffu); mv[3] = __uint_as_float(mq.y & 0xffff0000u); }
            float o[4];
#pragma unroll
            for (int i = 0; i < 4; ++i) o[i] = MODE == 0 ? gv[i] * sigmoidf_(v[i]) : (MODE == 1 ? mv[i] * v[i] : mv[i] + gv[i] * v[i]);
            u32x2 ov; ov.x = pk2(o[0], o[1]); ov.y = pk2(o[2], o[3]); *mp = ov; });
    }
};
struct EpiMergeCP {
    bf16_t* Mg; const bf16_t* GT;
    __device__ __forceinline__ void operator()(f32x4 (&acc)[2][2][4][2], const Unit& u, int wr, int wc, int fr, int fq) const {
        const int mode = u.batch; const int goff = mode == 0 ? 1024 : (mode == 1 ? 0 : 2048);
#pragma unroll
        for (int ai = 0; ai < 2; ++ai)
#pragma unroll
            for (int m = 0; m < 4; ++m) {
                const size_t r = (size_t)(u.pm * 256 + ai * 128 + wr * 64 + m * 16 + fr); const int c = u.pn * 128 + wc * 32 + 8 * fq;
                const u32x2 gq = *(const u32x2*)((const unsigned char*)GT + r * 3072 + goff + c);
                const float k255 = 1.f / 255.f;
                const f32x4 g0 = {(float)(gq.x & 255u) * k255, (float)((gq.x >> 8) & 255u) * k255, (float)((gq.x >> 16) & 255u) * k255, (float)(gq.x >> 24) * k255};
                const f32x4 g1 = {(float)(gq.y & 255u) * k255, (float)((gq.y >> 8) & 255u) * k255, (float)((gq.y >> 16) & 255u) * k255, (float)(gq.y >> 24) * k255};
                const f32x4 v0 = acc[ai][1][m][0], v1 = acc[ai][1][m][1]; f32x4 M0 = acc[ai][0][m][0], M1 = acc[ai][0][m][1];
                if (mode == 0) {
#pragma unroll
                    for (int i = 0; i < 4; ++i) { M0[i] = g0[i] * sigmoidf_(M0[i]) * v0[i]; M1[i] = g1[i] * sigmoidf_(M1[i]) * v1[i]; }
                } else { M0 += g0 * v0; M1 += g1 * v1; }
                if (mode == 2) { u32x4 ov; ov.x = pk2(M0[0], M0[1]); ov.y = pk2(M0[2], M0[3]); ov.z = pk2(M1[0], M1[1]); ov.w = pk2(M1[2], M1[3]); *(u32x4*)(Mg + r * DM + c) = ov; }
                acc[ai][0][m][0] = M0; acc[ai][0][m][1] = M1;
            }
    }
};
struct EpiMergeHalf {
    bf16_t* Mg; const bf16_t* GT;
    __device__ __forceinline__ void operator()(f32x4 (&acc)[2][2][4][2], const Unit& u, int wr, int wc, int fr, int fq) const {
        const int mode = u.batch; const int goff = mode == 1 ? 1024 : (mode == 2 ? 0 : 2048);
#pragma unroll
        for (int m = 0; m < 4; ++m)
#pragma unroll
            for (int bj = 0; bj < 2; ++bj) {
                const size_t r = (size_t)(u.pm * 128 + wr * 64 + m * 16 + fr); const int c = u.pn * 256 + bj * 128 + wc * 32 + 8 * fq;
                const f32x4 v0 = acc[0][bj][m][0], v1 = acc[0][bj][m][1]; f32x4 M0 = acc[1][bj][m][0], M1 = acc[1][bj][m][1];
                if (mode == 0) {
#pragma unroll
                    for (int i = 0; i < 4; ++i) { M0[i] = sigmoidf_(v0[i]); M1[i] = sigmoidf_(v1[i]); }
                } else {
                    const u32x4 gq = *(const u32x4*)(GT + r * 3072 + goff + c);
                    float gf[8]; unpack8(gq, gf);
                    const f32x4 g0 = {gf[0], gf[1], gf[2], gf[3]}, g1 = {gf[4], gf[5], gf[6], gf[7]};
                    if (mode == 1) { M0 = M0 * v0 * g0; M1 = M1 * v1 * g1; } else { M0 += g0 * v0; M1 += g1 * v1; }
                    if (mode == 3) { u32x4 ov; ov.x = pk2(M0[0], M0[1]); ov.y = pk2(M0[2], M0[3]); ov.z = pk2(M1[0], M1[1]); ov.w = pk2(M1[2], M1[3]); *(u32x4*)(Mg + r * DM + c) = ov; }
                }
                acc[1][bj][m][0] = M0; acc[1][bj][m][1] = M1;
            }
    }
};
struct EpiMergeAll {
    bf16_t* Mg; const bf16_t* GT;
    __device__ __forceinline__ void operator()(const f32x4 (&acc)[2][2][4][2], const Unit& u, int wr, int wc, int fr, int fq) const {
        const int mode = u.batch; const int goff = mode == 0 ? 1024 : (mode == 2 ? 0 : 2048);
        pg8::epi_foreach(acc, wr, wc, fr, fq, [&](int rl, int cl, const f32x4& v) {
            const size_t r = (size_t)(u.pm * 256 + rl); const int c = u.pn * 256 + cl;
            u32x2* mp = (u32x2*)(Mg + r * DM + c);
            u32x2 gq = {0x3f803f80u, 0x3f803f80u}, mq = {0u, 0u};
            if (mode != 1) gq = *(const u32x2*)(GT + r * 3072 + goff + c);
            if (mode != 0) mq = *mp;
            const float g0 = bf2f(gq.x & 0xffffu), g1 = __uint_as_float(gq.x & 0xffff0000u), g2 = bf2f(gq.y & 0xffffu), g3 = __uint_as_float(gq.y & 0xffff0000u);
            const float m0 = bf2f(mq.x & 0xffffu), m1 = __uint_as_float(mq.x & 0xffff0000u), m2 = bf2f(mq.y & 0xffffu), m3 = __uint_as_float(mq.y & 0xffff0000u);
            float t0 = v[0], t1 = v[1], t2 = v[2], t3 = v[3];
            if (mode == 0) { t0 = sigmoidf_(t0); t1 = sigmoidf_(t1); t2 = sigmoidf_(t2); t3 = sigmoidf_(t3); }
            float o0, o1, o2, o3;
            if (mode == 1) { o0 = m0 * t0; o1 = m1 * t1; o2 = m2 * t2; o3 = m3 * t3; }
            else { o0 = m0 + g0 * t0; o1 = m1 + g1 * t1; o2 = m2 + g2 * t2; o3 = m3 + g3 * t3; }
            u32x2 ov; ov.x = pk2(o0, o1); ov.y = pk2(o2, o3); *mp = ov; });
    }
};
struct EpiResid {
    float* xc; float* out; const float* mods_l; int gi; float* PB;
    __device__ __forceinline__ void operator()(const f32x4 (&acc)[2][2][4][2], const Unit& u, int wr, int wc, int fr, int fq) const {
        const TileRows tr(u.pm);
        float* xb = tr.tb == 0 ? xc + (size_t)tr.b * CTXL * DM : out + ((size_t)tr.b * SEQ + (tr.tb - 1) * 256) * DM;
        const float* gate = mods_l + (size_t)(tr.tb == 0 ? 8 : tr.b) * 6144 + gi * DM;
        if (u.batch == 0) {
            pg8::epi_foreach(acc, wr, wc, fr, fq, [&](int rl, int cl, const f32x4& v) {
                const int c = u.pn * 256 + cl; float* p = xb + (size_t)rl * DM + c;
                const f32x4 gt = *(const f32x4*)(gate + c); f32x4 xv = *(f32x4*)p; xv += gt * v; *(f32x4*)p = xv; });
        } else {
            float* pb = PB + (size_t)((u.batch - 1) * 32 + u.aux) * 65536;
            pg8::epi_foreach(acc, wr, wc, fr, fq, [&](int rl, int cl, const f32x4& v) {
                const f32x4 gt = *(const f32x4*)(gate + u.pn * 256 + cl); *(f32x4*)(pb + rl * 256 + cl) = gt * v; });
        }
    }
};
struct EpiSqRelu {
    bf16_t* Hd;
    __device__ __forceinline__ void operator()(const f32x4 (&acc)[2][2][4][2], const Unit& u, int wr, int wc, int fr, int fq) const {
        pg8::epi_foreach(acc, wr, wc, fr, fq, [&](int rl, int cl, const f32x4& v) {
            float o[4];
#pragma unroll
            for (int i = 0; i < 4; ++i) { const float r = fmaxf(v[i], 0.f); o[i] = r * r; }
            u32x2 ov; ov.x = pk2(o[0], o[1]); ov.y = pk2(o[2], o[3]);
            *(u32x2*)(Hd + (size_t)(u.pm * 256 + rl) * HID + u.pn * 256 + cl) = ov; });
    }
};

__device__ __forceinline__ void transpose_item(const float* W, int K, int N, bf16_t* WT, LAS float* scr, int item, int lane, bool blk = false) {
    const int nblk = N / 32, kb = item / nblk, nbk = item - kb * nblk, k0 = 64 * kb, n0 = 32 * nbk;
#pragma unroll 8
    for (int i = 0; i < 32; ++i) { const int kk = 2 * i + (lane >> 5); scr[kk * 33 + (lane & 31)] = W[(size_t)(k0 + kk) * N + n0 + (lane & 31)]; }
    asm volatile("s_waitcnt lgkmcnt(0)" ::: "memory");
    const int c = lane & 7;
#pragma unroll
    for (int j = 0; j < 4; ++j) { const int n = (lane >> 3) + 8 * j; const LAS float* s = scr + (8 * c) * 33 + n;
        u32x4 o; o.x = pk2(s[0 * 33], s[1 * 33]); o.y = pk2(s[2 * 33], s[3 * 33]); o.z = pk2(s[4 * 33], s[5 * 33]); o.w = pk2(s[6 * 33], s[7 * 33]);
        *(u32x4*)(blk ? WT + ((size_t)kb * N + (n0 + n)) * 64 + 8 * c : WT + (size_t)(n0 + n) * K + k0 + 8 * c) = o; }
    asm volatile("s_waitcnt lgkmcnt(0)" ::: "memory");
}

__device__ __forceinline__ void build_tmap(LAS unsigned char* tmap) {
    const int tid = tid_();
    for (int i = tid; i < 544; i += 512) tmap[i] = 0xff;
    __syncthreads();
    if (tid < 32) { int pm, pn; pg8::std_map(512 + tid, 136, 4, pm, pn); tmap[pm * 4 + pn] = (unsigned char)tid; }
    __syncthreads();
}
__device__ __forceinline__ bool fold_partials(f32x4 (&v)[4], const LAS unsigned char* tmap, const float* PB, int r, int lane) {
    const int pm = r >> 8, rl = r & 255; bool any = false;
#pragma unroll
    for (int j = 0; j < 4; ++j) { const int q = tmap[pm * 4 + j];
        if (q != 0xff) { any = true;
#pragma unroll
            for (int sl = 0; sl < 4; ++sl) v[j] += *(const f32x4*)(PB + ((size_t)(sl * 32 + q) * 256 + rl) * 256 + lane * 4); } }
    return any;
}
__device__ __forceinline__ void prenorm_row(float* xr, const float* g, const float* shift, const float* scale, bf16_t* orow, int lane, const LAS unsigned char* tmap, const float* PB, int r) {
    f32x4 v[4]; float s = 0.f;
#pragma unroll
    for (int j = 0; j < 4; ++j) v[j] = ((const f32x4*)xr)[lane + 64 * j];
    if (PB) { if (fold_partials(v, tmap, PB, r, lane)) {
#pragma unroll
        for (int j = 0; j < 4; ++j) ((f32x4*)xr)[lane + 64 * j] = v[j]; } }
#pragma unroll
    for (int j = 0; j < 4; ++j) s += (v[j].x * v[j].x + v[j].y * v[j].y) + (v[j].z * v[j].z + v[j].w * v[j].w);
    const float rstd = rsqrtf(wave_sum(s) * (1.f / DM) + 1e-6f);
#pragma unroll
    for (int j = 0; j < 4; ++j) {
        const f32x4 gg = ((const f32x4*)g)[lane + 64 * j], sh = ((const f32x4*)shift)[lane + 64 * j], sc = ((const f32x4*)scale)[lane + 64 * j];
        const f32x4 y = v[j] * rstd * gg * (sc + 1.f) + sh;
        u32x2 o; o.x = pk2(y.x, y.y); o.y = pk2(y.z, y.w);
        ((u32x2*)orow)[lane + 64 * j] = o;
    }
}
__device__ __forceinline__ void prenorm_all(KArgs& a, LAS unsigned char* lds, const float* g, const float* mods_l, int si, bf16_t* Hn, const float* PB) {
    LAS unsigned char* tmap = lds + 140000;
    if (PB) build_tmap(tmap);
    const int lane = tid_() & 63, gw = bid_() * 8 + (tid_() >> 6), ngw = nblk_() * 8;
    for (int r = gw; r < MTOK; r += ngw) {
        const int b = r / TPB, t = r - b * TPB; const float* md = mods_l + (size_t)(t < CTXL ? 8 : b) * 6144;
        prenorm_row(xrow(a, r), g, md + si * DM, md + (si + 1) * DM, Hn + (size_t)r * DM, lane, tmap, PB, r);
    }
}

__device__ __forceinline__ void phase_pre(KArgs& a, LAS unsigned char* lds) {
    const int tid = tid_(), bid = bid_();
    {
        LAS float* s = (LAS float*)lds;
        LAS float* red = (LAS float*)(lds + 36864);
        for (int i = tid; i < 9 * 1024; i += 512) { const int j = i >> 10, k = i & 1023; const float v = (j < 8) ? a.c[j * 1024 + k] : a.c_ctx[k]; s[i] = v / (1.f + __expf(-v)); }
        __syncthreads();
        const int cl = tid & 127, kq = tid >> 7;
        for (int task = bid; task < 4 * 48; task += nblk_()) {
            const int n = task * 128 + cl, l = n / 6144, col = n - l * 6144;
            const float* w = a.w_mod + (size_t)l * 1024 * 6144 + col + (size_t)kq * 256 * 6144;
            float acc[9];
#pragma unroll
            for (int j = 0; j < 9; ++j) acc[j] = 0.f;
#pragma unroll 8
            for (int k = 0; k < 256; ++k) { const float wv = w[(size_t)k * 6144];
#pragma unroll
                for (int j = 0; j < 9; ++j) acc[j] += s[j * 1024 + kq * 256 + k] * wv; }
#pragma unroll
            for (int j = 0; j < 9; ++j) red[(kq * 9 + j) * 128 + cl] = acc[j];
            __syncthreads();
            float* mods = (float*)(a.ws + OFF_MODS);
            for (int i = tid; i < 9 * 128; i += 512) { const int j = i >> 7, c2 = i & 127, n2 = task * 128 + c2, l2 = n2 / 6144, col2 = n2 - l2 * 6144;
                mods[(size_t)(l2 * 9 + j) * 6144 + col2] = red[(0 * 9 + j) * 128 + c2] + red[(1 * 9 + j) * 128 + c2] + red[(2 * 9 + j) * 128 + c2] + red[(3 * 9 + j) * 128 + c2] + a.b_mod[l2 * 6144 + col2]; }
            __syncthreads();
        }
    }
    const size_t gt = (size_t)bid * 512 + tid, gn = (size_t)nblk_() * 512;
    for (size_t i = gt; i < (size_t)NB * SEQ * DM / 4; i += gn) ((f32x4*)a.out)[i] = ((const f32x4*)a.x)[i];
    for (size_t i = gt; i < (size_t)NB * CTXL * DM / 4; i += gn) ((f32x4*)(a.ws + OFF_XC))[i] = ((const f32x4*)a.ctx)[i];
    f32x2* AP = (f32x2*)(a.ws + OFF_AP); f32x2* BB = (f32x2*)(a.ws + OFF_BB);
    for (size_t e = gt; e < (size_t)4 * 2 * 32 * 64 * 33; e += gn) {
        const int idx = (int)(e / 33), d = (int)(e - (size_t)idx * 33);
        const float lr = fminf(a.lam_re[idx], -1e-4f), li = a.lam_im[idx], dt = expf(a.log_step[idx >> 6]);
        const float mag = expf(lr * dt * (float)d); float sn, cs; sincosf(li * dt * (float)d, &sn, &cs);
        AP[e] = (f32x2){mag * cs, mag * sn};
    }
    for (size_t e = gt; e < (size_t)4 * 2 * 32 * 64 * 16; e += gn) {
        const int idx = (int)(e >> 4);
        const float lr = fminf(a.lam_re[idx], -1e-4f), li = a.lam_im[idx], dt = expf(a.log_step[idx >> 6]);
        const float mag = expf(lr * dt); float sn, cs; sincosf(li * dt, &sn, &cs);
        const float nr = mag * cs - 1.f, ni = mag * sn, den = lr * lr + li * li;
        const float qr = (nr * lr + ni * li) / den, qi = (ni * lr - nr * li) / den;
        const float br = a.b_re[e], bi = a.b_im[e];
        BB[e] = (f32x2){qr * br - qi * bi, qr * bi + qi * br};
    }
}

__device__ __forceinline__ void weight_transposes(KArgs& a, LAS unsigned char* lds, int l, int it_lo, int it_hi, int blk0, int nblk) {
    const int tid = tid_(), lane = tid & 63, wave = tid >> 6, gw = (bid_() - blk0) * 8 + wave, ngw = nblk * 8;
    LAS float* scr = (LAS float*)(lds + wave * 8448);
    bf16_t* WA = (bf16_t*)(a.ws + OFF_WA); bf16_t* WB = (bf16_t*)(a.ws + OFF_WB);
    for (int it = it_lo + gw; it < it_hi; it += ngw) {
        int r = it, K, N; const float* W; bf16_t* WT; bool blk = false;
        if (r < 3328) { W = a.w_in + (size_t)l * DM * INW; K = DM; N = INW; WT = WA + WA_WIN / 2; }
        else if ((r -= 3328) < 256) { W = a.conv_out + (size_t)l * 512 * DM; K = 512; N = DM; WT = WA + WA_CONV / 2; }
        else if ((r -= 256) < 256) { W = a.glu_a + (size_t)l * 512 * DM; K = 512; N = DM; WT = WA + WA_GLUA / 2; }
        else if ((r -= 256) < 256) { W = a.glu_b + (size_t)l * 512 * DM; K = 512; N = DM; WT = WA + WA_GLUB / 2; }
        else if ((r -= 256) < 256) { W = a.na_out + (size_t)l * 512 * DM; K = 512; N = DM; WT = WA + WA_NA / 2; }
        else if ((r -= 256) < 512) { W = a.w_out + (size_t)l * DM * DM; K = DM; N = DM; WT = WA + WA_WOUT / 2; }
        else if ((r -= 512) < 2048) { W = a.mlp_w1 + (size_t)l * DM * HID; K = DM; N = HID; WT = WB; }
        else { r -= 2048; W = a.mlp_w2 + (size_t)l * HID * DM; K = HID; N = DM; WT = WB + (size_t)HID * DM; blk = true; }
        transpose_item(W, K, N, WT, scr, r, lane, blk);
    }
}
__device__ __forceinline__ void s5_tables(KArgs& a, int l, int blk0, int nblk) {
    const int tid = tid_();
    const size_t gt = (size_t)(bid_() - blk0) * 512 + tid, gn = (size_t)nblk * 512;
    const f32x2* AP = (const f32x2*)(a.ws + OFF_AP) + (size_t)l * 2 * 32 * 64 * 33;
    const f32x2* BB = (const f32x2*)(a.ws + OFF_BB) + (size_t)l * 2 * 32 * 64 * 16;
    const float* cre = a.c_re + (size_t)l * 2 * 32 * 16 * 64; const float* cim = a.c_im + (size_t)l * 2 * 32 * 16 * 64;
    float* KT = (float*)(a.ws + OFF_KTAB);
    for (size_t e = gt; e < (size_t)32 * 2 * 32 * 16 * 4; e += gn) {
        const int mq = (int)(e & 3), n = (int)((e >> 2) & 15), d = (int)((e >> 6) & 31), dir = (int)((e >> 11) & 1), gI = (int)(e >> 12);
        const int dg = dir * 32 + gI; f32x4 acc = {0.f, 0.f, 0.f, 0.f};
#pragma unroll 8
        for (int p = 0; p < 64; ++p) {
            const f32x2 ap = AP[((size_t)dg * 64 + p) * 33 + d];
            const f32x4 b01 = *(const f32x4*)(BB + ((size_t)dg * 64 + p) * 16 + 4 * mq), b23 = *(const f32x4*)(BB + ((size_t)dg * 64 + p) * 16 + 4 * mq + 2);
            const float cr = cre[((size_t)dg * 16 + n) * 64 + p], ci = cim[((size_t)dg * 16 + n) * 64 + p];
            const float wr_ = cr * ap.x - ci * ap.y, wi_ = cr * ap.y + ci * ap.x;
            acc[0] += wr_ * b01[0] - wi_ * b01[1]; acc[1] += wr_ * b01[2] - wi_ * b01[3];
            acc[2] += wr_ * b23[0] - wi_ * b23[1]; acc[3] += wr_ * b23[2] - wi_ * b23[3];
        }
        *(f32x4*)(KT + ((((size_t)gI * 2 + dir) * 32 + d) * 16 + n) * 16 + 4 * mq) = acc;
    }
    bf16_t* WET = (bf16_t*)(a.ws + OFF_WET);
    for (size_t e = gt; e < (size_t)32 * 256 * 64; e += gn) {
        const int k8 = (int)(e & 63), col = (int)((e >> 6) & 255), gI = (int)(e >> 14);
        const int dir = col >> 7, part = (col >> 6) & 1, p = col & 63, s = k8 >> 1, m0 = (k8 & 1) * 8, dg = dir * 32 + gI;
        const f32x2 ap = AP[((size_t)dg * 64 + p) * 33 + (dir == 0 ? TCH - 1 - s : s)];
        const f32x4* bbp = (const f32x4*)(BB + ((size_t)dg * 64 + p) * 16 + m0);
        float z[8];
#pragma unroll
        for (int i = 0; i < 4; ++i) { const f32x4 bb = bbp[i];
            z[2 * i] = part == 0 ? ap.x * bb[0] - ap.y * bb[1] : ap.x * bb[1] + ap.y * bb[0];
            z[2 * i + 1] = part == 0 ? ap.x * bb[2] - ap.y * bb[3] : ap.x * bb[3] + ap.y * bb[2]; }
        u32x4 o; o.x = pk2(z[0], z[1]); o.y = pk2(z[2], z[3]); o.z = pk2(z[4], z[5]); o.w = pk2(z[6], z[7]);
        *(u32x4*)(WET + ((size_t)gI * 256 + col) * 512 + k8 * 8) = o;
    }
    bf16_t* BTY = (bf16_t*)(a.ws + OFF_BTY);
    for (size_t e = gt; e < (size_t)32 * 512 * 32; e += gn) {
        const int j8 = (int)(e & 31), row = (int)((e >> 5) & 511), gI = (int)(e >> 14);
        const int dir = j8 >> 4, part = (j8 >> 3) & 1, p0 = (j8 & 7) * 8, t = row >> 4, n = row & 15, dg = dir * 32 + gI, idx = dir == 0 ? t + 1 : TCH - t;
        const f32x4 cr0 = *(const f32x4*)(cre + ((size_t)dg * 16 + n) * 64 + p0), cr1 = *(const f32x4*)(cre + ((size_t)dg * 16 + n) * 64 + p0 + 4);
        const f32x4 ci0 = *(const f32x4*)(cim + ((size_t)dg * 16 + n) * 64 + p0), ci1 = *(const f32x4*)(cim + ((size_t)dg * 16 + n) * 64 + p0 + 4);
        float z[8];
#pragma unroll
        for (int i = 0; i < 8; ++i) { const f32x2 ap = AP[((size_t)dg * 64 + p0 + i) * 33 + idx];
            const float cr = i < 4 ? cr0[i & 3] : cr1[i & 3], ci = i < 4 ? ci0[i & 3] : ci1[i & 3];
            z[i] = part == 0 ? cr * ap.x - ci * ap.y : -(cr * ap.y + ci * ap.x); }
        u32x4 o; o.x = pk2(z[0], z[1]); o.y = pk2(z[2], z[3]); o.z = pk2(z[4], z[5]); o.w = pk2(z[6], z[7]);
        *(u32x4*)(BTY + ((size_t)gI * 512 + row) * 768 + 512 + j8 * 8) = o;
    }
}
__device__ __forceinline__ void phase_a(KArgs& a, LAS unsigned char* lds, int l) {
    const int nb = nblk_();
    if (l == 0 || nb != 256) { weight_transposes(a, lds, l, 0, 8960, 0, nb); s5_tables(a, l, 0, nb); }
    else weight_transposes(a, lds, l, 4864, 8960, 0, nb);
    const float* mods_l = (const float*)(a.ws + OFF_MODS) + (size_t)l * 9 * 6144;
    __syncthreads();
    prenorm_all(a, lds, a.norm1_g + l * DM, mods_l, 0, (bf16_t*)(a.ws + OFF_HN), (l > 0 && nblk_() == 256) ? (const float*)(a.ws + OFF_A2) : nullptr);
}

__device__ __forceinline__ void toeplitz_fill(KArgs& a, int l) {
    const size_t gt = (size_t)bid_() * 512 + tid_(), gn = (size_t)nblk_() * 512;
    const float* KT = (const float*)(a.ws + OFF_KTAB); bf16_t* BTY = (bf16_t*)(a.ws + OFF_BTY);
    const float* dsk = a.s5_d + l * 512;
    for (size_t e = gt; e < (size_t)32 * 512 * 64; e += gn) {
        const int k8 = (int)(e & 63), row = (int)((e >> 6) & 511), gI = (int)(e >> 15);
        const int t = row >> 4, n = row & 15, s = k8 >> 1, m0 = (k8 & 1) * 8;
        float v[8];
        if (s == t) {
            const float* kf = KT + ((((size_t)gI * 2 + 0) * 32 + 0) * 16 + n) * 16 + m0; const float* kb = KT + ((((size_t)gI * 2 + 1) * 32 + 0) * 16 + n) * 16 + m0;
#pragma unroll
            for (int i = 0; i < 8; ++i) v[i] = kf[i] + kb[i] + ((m0 + i) == n ? dsk[gI * 16 + n] : 0.f);
        } else {
            const int dir = s < t ? 0 : 1, d = s < t ? t - s : s - t;
            const float* kk = KT + ((((size_t)gI * 2 + dir) * 32 + d) * 16 + n) * 16 + m0;
#pragma unroll
            for (int i = 0; i < 8; ++i) v[i] = kk[i];
        }
        u32x4 o; o.x = pk2(v[0], v[1]); o.y = pk2(v[2], v[3]); o.z = pk2(v[4], v[5]); o.w = pk2(v[6], v[7]);
        *(u32x4*)(BTY + ((size_t)gI * 512 + row) * 768 + k8 * 8) = o;
    }
}

__device__ __forceinline__ void carry_scan(KArgs& a, int l) {
    const int gt = bid_() * 512 + tid_();
    if (gt >= 8 * 32 * 2 * 64) return;
    const int p = gt & 63, dir = (gt >> 6) & 1, gI = (gt >> 7) & 31, b = gt >> 12;
    const f32x2 aT = ((const f32x2*)(a.ws + OFF_AP))[((((size_t)l * 2 + dir) * 32 + gI) * 64 + p) * 33 + TCH];
    const float* E = (const float*)(a.ws + OFF_R2 + SZ_ACT) + ((size_t)gI * NCR + b * CPB) * 256 + dir * 128 + p;
    bf16_t* H = (bf16_t*)(a.ws + OFF_A2) + ((size_t)gI * NCR + b * CPB) * 768 + 512 + dir * 128 + p;
    float hr = 0.f, hi = 0.f;
    for (int i0 = 0; i0 < CPB; i0 += 8) {
        float er[8], ei[8]; int cc[8];
#pragma unroll
        for (int j = 0; j < 8; ++j) { const int i = i0 + j; cc[j] = dir == 0 ? i : (i < 8 ? 7 - i : CPB + 7 - i); er[j] = E[(size_t)cc[j] * 256]; ei[j] = E[(size_t)cc[j] * 256 + 64]; }
#pragma unroll
        for (int j = 0; j < 8; ++j) {
            H[(size_t)cc[j] * 768] = (bf16_t)(pk2(hr, 0.f) & 0xffffu); H[(size_t)cc[j] * 768 + 64] = (bf16_t)(pk2(hi, 0.f) & 0xffffu);
            const float nr = aT.x * hr - aT.y * hi + er[j], ni = aT.x * hi + aT.y * hr + ei[j]; hr = nr; hi = ni;
        }
    }
}

__device__ __forceinline__ void conv_all(KArgs& a, int l) {
    const size_t gt = (size_t)bid_() * 512 + tid_(), gn = (size_t)nblk_() * 512;
    const bf16_t* PA = (const bf16_t*)(a.ws + OFF_R1); bf16_t* AC = (bf16_t*)(a.ws + OFF_R2);
    const float* cw = a.conv_w + l * 3 * 512;
    for (size_t e = gt; e < (size_t)MTOK * 64; e += gn) {
        const int r = (int)(e >> 6), c0 = (int)(e & 63) * 8; const int t = r % TPB;
        const bf16_t* pr = PA + (size_t)r * PALD + c0;
        float xa[8], xb[8], xc[8], vm[8], vp[8];
        unpack8(*(const u32x4*)pr, xa); unpack8(*(const u32x4*)(pr + 512), xb); unpack8(*(const u32x4*)(pr + 1024), xc);
        const bool hasm = (t != 0 && t != CTXL), hasp = (t != CTXL - 1 && t != TPB - 1);
        if (hasm) { float q1[8], q2[8]; unpack8(*(const u32x4*)(pr - PALD), q1); unpack8(*(const u32x4*)(pr - PALD + 1024), q2);
#pragma unroll
            for (int i = 0; i < 8; ++i) vm[i] = q1[i] * q2[i]; }
        else {
#pragma unroll
            for (int i = 0; i < 8; ++i) vm[i] = 0.f; }
        if (hasp) { float q1[8], q2[8]; unpack8(*(const u32x4*)(pr + PALD), q1); unpack8(*(const u32x4*)(pr + PALD + 1024), q2);
#pragma unroll
            for (int i = 0; i < 8; ++i) vp[i] = q1[i] * q2[i]; }
        else {
#pragma unroll
            for (int i = 0; i < 8; ++i) vp[i] = 0.f; }
        float o[8];
#pragma unroll
        for (int i = 0; i < 8; ++i) o[i] = xb[i] * (cw[c0 + i] * vm[i] + cw[512 + c0 + i] * (xa[i] * xc[i]) + cw[1024 + c0 + i] * vp[i]);
        u32x4 ov; ov.x = pk2(o[0], o[1]); ov.y = pk2(o[2], o[3]); ov.z = pk2(o[4], o[5]); ov.w = pk2(o[6], o[7]);
        *(u32x4*)(AC + (size_t)r * 512 + c0) = ov;
    }
}

#define MFMA32(a, b, c) __builtin_amdgcn_mfma_f32_32x32x16_bf16((a), (b), (c), 0, 0, 0)
__device__ __forceinline__ void attn_dma_tile(const bf16_t* KHb, const bf16_t* VTb, int tt, int lane, LAS unsigned char* buf) {
    const int kl = lane >> 3, pos = lane & 7;
#pragma unroll
    for (int i = 0; i < 4; ++i) __builtin_amdgcn_global_load_lds((const unsigned*)(KHb + (size_t)(tt + 8 * i + kl) * 64 + ((pos ^ kl ^ (i & 1)) << 3)), (LAS unsigned*)(buf + i * 1024), 16, 0, 0);
    const bf16_t* vp = VTb + ((size_t)(tt >> 3) * 64 + lane) * 8;
#pragma unroll
    for (int j = 0; j < 4; ++j) __builtin_amdgcn_global_load_lds((const unsigned*)(vp + (size_t)j * 512), (LAS unsigned*)(buf + 4096 + j * 1024), 16, 0, 0);
}
__device__ __forceinline__ void attn_read_tile(const LAS unsigned char* buf, int lane, int q32, int g, bf16x8 (&kf)[4], bf16x8 (&vf)[2][2]) {
    const int ki = q32 >> 3, kl = q32 & 7;
#pragma unroll
    for (int ks = 0; ks < 4; ++ks) kf[ks] = *(const LAS bf16x8*)(buf + ki * 1024 + (kl * 8 + ((2 * ks + g) ^ kl ^ (ki & 1))) * 16);
#pragma unroll
    for (int d = 0; d < 2; ++d)
#pragma unroll
        for (int s2 = 0; s2 < 2; ++s2) {
            const u32x4 c0 = *(const LAS u32x4*)(buf + 4096 + (2 * s2) * 1024 + (32 * d + q32) * 16), c1 = *(const LAS u32x4*)(buf + 4096 + (2 * s2 + 1) * 1024 + (32 * d + q32) * 16);
            const u32x4 w = {g ? c0.z : c0.x, g ? c0.w : c0.y, g ? c1.z : c1.x, g ? c1.w : c1.y}; vf[d][s2] = __builtin_bit_cast(bf16x8, w);
        }
}
__device__ __forceinline__ void attn_all(KArgs& a, LAS unsigned char* lds, int l) {
    const int tid = tid_(), lane = tid & 63, wave = __builtin_amdgcn_readfirstlane(tid >> 6), q32 = lane & 31, g = lane >> 5;
    LAS float* rpb_s = (LAS float*)(lds + 1024);
    for (int i = tid; i < 3720; i += 512) rpb_s[i] = a.na_rpb[l * 3720 + i] * 1.44269504f;
    LAS unsigned char* wbuf = lds + 16384 + wave * 16384;
    __syncthreads();
    const bf16_t* PA = (const bf16_t*)(a.ws + OFF_R1); const bf16_t* VT = (const bf16_t*)(a.ws + OFF_VT); const bf16_t* KH = (const bf16_t*)(a.ws + OFF_KH); bf16_t* OA = (bf16_t*)(a.ws + OFF_R2 + 2 * SZ_ACT);
    const int nb = nblk_(), bid = nb - 1 - bid_(), ntb = 1024 + (l < DEPTH - 1 ? 64 : 0);
    const bool xl = (nb & 7) == 0;
    const int gw = xl ? (bid >> 3) * 8 + wave : bid * 8 + wave, ngw = xl ? nb : nb * 8, tend = xl ? ntb : 8 * ntb;
    for (int ti = gw; ti < tend; ti += ngw) {
        const int b = xl ? (bid & 7) : ti / ntb, task = xl ? ti : ti - b * ntb;
        int h, qtok, n_local = 0, krow_lo = 0, tc0 = 0, qrow_g = 0, qcol = 0, r0q = 0;
        float cadd[16];
#pragma unroll
        for (int j = 0; j < 16; ++j) cadd[j] = 0.f;
        if (task < 1024) {
            h = task & 7; const int cb = (task >> 3) & 3, rp = task >> 5;
            const int rr0 = 2 * rp; qrow_g = rr0 + (q32 >> 4); qcol = cb * 16 + (q32 & 15);
            qtok = b * TPB + CTXL + qrow_g * 64 + qcol;
            r0q = min(max(qrow_g - 4, 0), 56); const int csq = min(max(qcol - 8, 0), 48);
            tc0 = min(max(cb * 16 - 8, 0), 32);
            krow_lo = min(max(rr0 - 4, 0), 56); n_local = min(max(rr0 - 3, 0), 56) + 8 - krow_lo;
#pragma unroll
            for (int j = 0; j < 16; ++j) { const int ko = 8 * (j >> 2) + 4 * g + (j & 3); cadd[j] = (unsigned)(tc0 + ko - csq) < 16u ? 0.f : -1e30f; }
        } else { const int j = task - 1024; h = j & 7; qtok = b * TPB + (j >> 3) * 32 + q32; }
        const bf16_t* KHb = KH + (size_t)(b * 8 + h) * TPB * 64; const bf16_t* VTb = VT + (size_t)(b * 8 + h) * 544 * 512;
        bf16x8 qf[4];
        { const bf16_t* qp = PA + (size_t)qtok * PALD + 1536 + h * 64 + g * 8;
#pragma unroll
          for (int ks = 0; ks < 4; ++ks) qf[ks] = *(const bf16x8*)(qp + ks * 16); }
        f32x16 O0, O1;
#pragma unroll
        for (int j = 0; j < 16; ++j) { O0[j] = 0.f; O1[j] = 0.f; }
        float mrun = -1e29f, lsum = 0.f;
        const int ntiles = n_local + 8;
        const LAS float* bp0 = rpb_s + h * 465 + (7 - qrow_g) * 31 + (tc0 + 4 * g - qcol + 15);
        auto tile_tt = [&](int t) { const int tc = t < ntiles ? t : ntiles - 1; return tc < n_local ? CTXL + (krow_lo + tc) * 64 + tc0 : (tc - n_local) * 32; };
        auto process = [&](int t) {
            asm volatile("s_waitcnt vmcnt(8)" ::: "memory");
            bf16x8 kf[4], vf[2][2];
            attn_read_tile(wbuf + (t & 1) * 8192, lane, q32, g, kf, vf);
            f32x16 S;
#pragma unroll
            for (int j = 0; j < 16; ++j) S[j] = 0.f;
#pragma unroll
            for (int ks = 0; ks < 4; ++ks) S = MFMA32(kf[ks], qf[ks], S);
            asm volatile("s_waitcnt lgkmcnt(0)" ::: "memory");
            attn_dma_tile(KHb, VTb, tile_tt(t + 2), lane, wbuf + (t & 1) * 8192);
            float sv[16];
            if (t < n_local) {
                const int krow = krow_lo + t; const float radd = (unsigned)(krow - r0q) < 8u ? 0.f : -1e30f;
                const LAS float* bp = bp0 + krow * 31;
                float bv[16];
#pragma unroll
                for (int j = 0; j < 16; ++j) bv[j] = bp[8 * (j >> 2) + (j & 3)];
#pragma unroll
                for (int j = 0; j < 16; ++j) sv[j] = fmaf(S[j], 0.125f * 1.44269504f, bv[j] + (cadd[j] + radd));
            } else {
#pragma unroll
                for (int j = 0; j < 16; ++j) sv[j] = S[j] * (0.125f * 1.44269504f);
            }
            float mx = sv[0];
#pragma unroll
            for (int j = 1; j < 16; ++j) mx = fmaxf(mx, sv[j]);
            mx = fmaxf(mx, __shfl_xor(mx, 32));
            const float mnew = fmaxf(mrun, mx);
            if (__any(mnew > mrun)) {
                const float resc = __builtin_amdgcn_exp2f(mrun - mnew);
                lsum *= resc;
#pragma unroll
                for (int j = 0; j < 16; ++j) { O0[j] *= resc; O1[j] *= resc; }
                mrun = mnew;
            }
            float p[16], ps = 0.f;
#pragma unroll
            for (int j = 0; j < 16; ++j) { p[j] = __builtin_amdgcn_exp2f(sv[j] - mrun); ps += p[j]; }
            lsum += ps;
            const u32x4 w0 = {pk2(p[0], p[1]), pk2(p[2], p[3]), pk2(p[4], p[5]), pk2(p[6], p[7])}, w1 = {pk2(p[8], p[9]), pk2(p[10], p[11]), pk2(p[12], p[13]), pk2(p[14], p[15])};
            const bf16x8 pb0 = __builtin_bit_cast(bf16x8, w0), pb1 = __builtin_bit_cast(bf16x8, w1);
            O0 = MFMA32(vf[0][0], pb0, O0); O0 = MFMA32(vf[0][1], pb1, O0);
            O1 = MFMA32(vf[1][0], pb0, O1); O1 = MFMA32(vf[1][1], pb1, O1);
        };
        attn_dma_tile(KHb, VTb, tile_tt(0), lane, wbuf);
        attn_dma_tile(KHb, VTb, tile_tt(1), lane, wbuf + 8192);
#pragma unroll 1
        for (int t = 0; t < ntiles; ++t) process(t);
        asm volatile("s_waitcnt vmcnt(0)" ::: "memory");
        const float inv = 1.f / (lsum + __shfl_xor(lsum, 32));
        bf16_t* op = OA + (size_t)qtok * 512 + h * 64 + 4 * g;
#pragma unroll
        for (int jq = 0; jq < 4; ++jq) {
            u32x2 o0, o1; o0.x = pk2(O0[4 * jq] * inv, O0[4 * jq + 1] * inv); o0.y = pk2(O0[4 * jq + 2] * inv, O0[4 * jq + 3] * inv);
            o1.x = pk2(O1[4 * jq] * inv, O1[4 * jq + 1] * inv); o1.y = pk2(O1[4 * jq + 2] * inv, O1[4 * jq + 3] * inv);
            *(u32x2*)(op + 8 * jq) = o0; *(u32x2*)(op + 32 + 8 * jq) = o1;
        }
    }
    __syncthreads();
}

__device__ __forceinline__ void final_norm(KArgs& a) {
    const int lane = tid_() & 63, gw = bid_() * 8 + (tid_() >> 6), ngw = nblk_() * 8;
    for (int r = gw; r < NB * SEQ; r += ngw) {
        float* xr = a.out + (size_t)r * DM; f32x4 v[4]; float s = 0.f;
#pragma unroll
        for (int j = 0; j < 4; ++j) { v[j] = ((const f32x4*)xr)[lane + 64 * j]; s += (v[j].x * v[j].x + v[j].y * v[j].y) + (v[j].z * v[j].z + v[j].w * v[j].w); }
        const float rstd = rsqrtf(wave_sum(s) * (1.f / DM) + 1e-6f);
#pragma unroll
        for (int j = 0; j < 4; ++j) ((f32x4*)xr)[lane + 64 * j] = v[j] * rstd * ((const f32x4*)a.final_g)[lane + 64 * j];
    }
}

__global__ __launch_bounds__(512, 2) void mega(Args a_) {
    extern __shared__ __attribute__((aligned(16))) unsigned char shm[];
    LAS unsigned char* lds = (LAS unsigned char*)shm;
    cg::grid_group grid = cg::this_grid();
    const int ph_lo = a_.ph_lo, ph_hi = a_.ph_hi;
    int ph = 0;
    volatile LAS unsigned* xst = (volatile LAS unsigned*)(lds + 147712);
    if (threadIdx.x < 4) xst[threadIdx.x] = 0u;
    __syncthreads();
    const XcdBarrier xb = xcd_barrier_post((unsigned*)(a_.ws + OFF_BAR), xst);
#define PH_BEGIN if (ph >= ph_lo && ph < ph_hi) { KArgs* ap_ = (KArgs*)__builtin_amdgcn_kernarg_segment_ptr(); asm volatile("" : "+s"(ap_)); KArgs& a = *ap_; \
        int l = lv; asm volatile("" : "+s"(l)); int G = gridDim.x, c = blockIdx.x; asm volatile("" : "+s"(G), "+s"(c)); unsigned char* ws = a.ws; (void)l; (void)G; (void)c; (void)ws;
#ifdef PROBE_SYNC2
#define PH_END if (ph + 1 < ph_hi) { grid.sync(); grid.sync(); grid.sync(); } } ++ph;
#else
#define PH_END if (ph + 1 < ph_hi) { if (ph_hi < 0) grid.sync();   else xcd_barrier(xb); } } ++ph;
#endif
#define WSP(off) ((bf16_t*)(ws + (off)))
#ifdef PROBE_PRE2
    { const int lv = 0; PH_BEGIN phase_pre(a, lds); __syncthreads(); phase_pre(a, lds); PH_END }
#else
    { const int lv = 0; PH_BEGIN phase_pre(a, lds); PH_END }
#endif
#pragma unroll 1
    for (int lv = 0; lv < DEPTH; ++lv) {
#if !defined(ONLYP) || ONLYP == 0
#ifdef PROBE_A2
        PH_BEGIN phase_a(a, lds, l); phase_a(a, lds, l); PH_END
#else
        PH_BEGIN phase_a(a, lds, l); PH_END
#endif
#endif
#if !defined(ONLYP) || ONLYP == 1
        PH_BEGIN {
            pg8::gemm_phase<false, true>(lds, pg8::In1Prob{WSP(OFF_HN), WSP(OFF_WA + WA_WIN), DM, DM, DM, G, c}, EpiIn1P{WSP(OFF_R1), WSP(OFF_A2), WSP(OFF_VT), WSP(OFF_KH)});
#ifdef PROBE_B2
            pg8::gemm_phase<false, true>(lds, pg8::In1Prob{WSP(OFF_HN), WSP(OFF_WA + WA_WIN), DM, DM, DM, G, c}, EpiIn1P{WSP(OFF_R1), WSP(OFF_A2), WSP(OFF_VT), WSP(OFF_KH)});
#endif
            toeplitz_fill(a, l);
#ifdef PROBE_T2
            toeplitz_fill(a, l);
#endif
        } PH_END
#endif
#if !defined(ONLYP) || ONLYP == 2
        PH_BEGIN {
            pg8::gemm_phase(lds, pg8::StdProb(WSP(OFF_A2), WSP(OFF_WET), 768, 512, 512, (size_t)NCR * 768, (size_t)256 * 512, 5, 1, 32, G, c), EpiE{(float*)(ws + OFF_R2 + SZ_ACT)});
            attn_all(a, lds, l);
#ifdef PROBE_ATTN2
            attn_all(a, lds, l);
#endif
        } PH_END
#endif
#if !defined(ONLYP) || ONLYP == 3
#ifdef PROBE_D2
        PH_BEGIN carry_scan(a, l); conv_all(a, l); carry_scan(a, l); conv_all(a, l); PH_END
#else
        PH_BEGIN carry_scan(a, l); conv_all(a, l); PH_END
#endif
#endif
#if !defined(ONLYP) || ONLYP == 4
        PH_BEGIN {
            pg8::gemm_phase<false, true>(lds, pg8::StdProb(WSP(OFF_A2), WSP(OFF_BTY), 768, 768, 768, (size_t)NCR * 768, (size_t)512 * 768, 5, 2, 32, G, c), EpiYP{WSP(OFF_R2 + SZ_ACT)});
            { pg8::StdProb P(WSP(OFF_HN), WSP(OFF_WA + WA_WIN) + (size_t)3584 * DM, DM, DM, DM, 0, 0, l == DEPTH - 1 ? 128 : 136, 12, 1, G, G - 1 - c);     P.skipctx = l == DEPTH - 1;
              pg8::gemm_phase<false, true>(lds, P, EpiGatesP{WSP(OFF_R1)}); }
#ifdef PROBE_E2
            pg8::gemm_phase<false, true>(lds, pg8::StdProb(WSP(OFF_A2), WSP(OFF_BTY), 768, 768, 768, (size_t)NCR * 768, (size_t)512 * 768, 5, 2, 32, G, c), EpiYP{WSP(OFF_R2 + SZ_ACT)});
            { pg8::StdProb P(WSP(OFF_HN), WSP(OFF_WA + WA_WIN) + (size_t)3584 * DM, DM, DM, DM, 0, 0, l == DEPTH - 1 ? 128 : 136, 12, 1, G, G - 1 - c);     P.skipctx = l == DEPTH - 1;
              pg8::gemm_phase<false, true>(lds, P, EpiGatesP{WSP(OFF_R1)}); }
#endif
        } PH_END
#endif
#if !defined(ONLYP) || ONLYP == 5
        PH_BEGIN {
            pg8::gemm_phase<false, true, true>(lds, pg8::CPProb{WSP(OFF_R2), WSP(OFF_WA), 512, 512, 512, G, c, l == DEPTH - 1 ? 128 : 136}, EpiMergeCP{WSP(OFF_HN), WSP(OFF_R1)});
            if (l < DEPTH - 1 && G == 256 && c >= 64) s5_tables(a, l + 1, 64, 192);
#ifdef PROBE_F2
            pg8::gemm_phase<true, true>(lds, pg8::HalfMergeProb{WSP(OFF_R2), WSP(OFF_WA), 512, 512, 512, G, c, l == DEPTH - 1 ? 256 : 272}, EpiMergeHalf{WSP(OFF_HN), WSP(OFF_R1)});
#endif
        } PH_END
#endif
#if !defined(ONLYP) || ONLYP == 6
        PH_BEGIN {
            const EpiResid E{(float*)(ws + OFF_XC), a.out, (const float*)(ws + OFF_MODS) + (size_t)l * 9 * 6144, 2, (float*)(ws + OFF_A2)};
            if (l == DEPTH - 1) { pg8::StdProb P(WSP(OFF_HN), WSP(OFF_WA + WA_WOUT), DM, DM, DM, 0, 0, 128, 4, 1, G, c); P.skipctx = true; pg8::gemm_phase(lds, P, E); }
            else pg8::gemm_phase(lds, pg8::TailProb<4>(WSP(OFF_HN), WSP(OFF_WA + WA_WOUT), DM, DM, G, c, G == 256), E);
        } PH_END
#endif
#if !defined(ONLYP) || ONLYP == 7
#ifdef PROBE_H2
        PH_BEGIN prenorm_all(a, lds, a.norm2_g + l * DM, (const float*)(ws + OFF_MODS) + (size_t)l * 9 * 6144, 3, WSP(OFF_HN), (l < DEPTH - 1 && G == 256) ? (const float*)(ws + OFF_A2) : nullptr); prenorm_all(a, lds, a.norm2_g + l * DM, (const float*)(ws + OFF_MODS) + (size_t)l * 9 * 6144, 3, WSP(OFF_HN), (l < DEPTH - 1 && G == 256) ? (const float*)(ws + OFF_A2) : nullptr); PH_END
#else
        PH_BEGIN prenorm_all(a, lds, a.norm2_g + l * DM, (const float*)(ws + OFF_MODS) + (size_t)l * 9 * 6144, 3, WSP(OFF_HN), (l < DEPTH - 1 && G == 256) ? (const float*)(ws + OFF_A2) : nullptr); PH_END
#endif
#endif
#if !defined(ONLYP) || ONLYP == 8
        PH_BEGIN {
            { pg8::StdProb P(WSP(OFF_HN), WSP(OFF_WB), DM, DM, DM, 0, 0, l == DEPTH - 1 ? 128 : 136, 16, 1, G, c); P.skipctx = l == DEPTH - 1;
              pg8::gemm_phase<false, true>(lds, P, EpiSqReluP{WSP(OFF_R1)}); }
            if (l < DEPTH - 1 && G == 256 && c >= 128) weight_transposes(a, lds, l + 1, 0, 4864, 128, 128);
#ifdef PROBE_I2
            { pg8::StdProb P(WSP(OFF_HN), WSP(OFF_WB), DM, DM, DM, 0, 0, l == DEPTH - 1 ? 128 : 136, 16, 1, G, c); P.skipctx = l == DEPTH - 1;
              pg8::gemm_phase<false, true>(lds, P, EpiSqReluP{WSP(OFF_R1)}); }
#endif
        } PH_END
#endif
#if !defined(ONLYP) || ONLYP == 9
        PH_BEGIN {
            const EpiResid E{(float*)(ws + OFF_XC), a.out, (const float*)(ws + OFF_MODS) + (size_t)l * 9 * 6144, 5, (float*)(ws + OFF_A2)};
            if (l == DEPTH - 1) { pg8::StdProb P(WSP(OFF_R1), WSP(OFF_WB) + (size_t)HID * DM, 64, 64, HID, 0, 0, 128, 4, 1, G, c); P.skipctx = true; P.ksA = (size_t)MTOK * 128; P.ksB = (size_t)DM * 128; pg8::gemm_phase(lds, P, E); }
            else { pg8::TailProb<4> P(WSP(OFF_R1), WSP(OFF_WB) + (size_t)HID * DM, 64, HID, G, c, G == 256); P.ksA = (size_t)MTOK * 128; P.ksB = (size_t)DM * 128; P.sliceA = (size_t)16 * MTOK * 64; P.sliceB = (size_t)16 * DM * 64;
                   pg8::gemm_phase(lds, P, E); }
        } PH_END
#endif
    }
    { const int lv = 0; PH_BEGIN final_norm(a); PH_END }
}

extern "C" void kernel_launch(void* const* d_in, const int* in_sizes, int n_in, void* d_out, int out_size, void* d_ws, size_t ws_size, hipStream_t stream) {
    static int grid = 0;
    if (grid == 0) {
        if (n_in != 27 || ws_size < WS_END) { fprintf(stderr, "kernel_launch: unexpected n_in %d or ws_size %zu (need %zu)\n", n_in, ws_size, (size_t)WS_END); grid = -1; return; }
        if (hipFuncSetAttribute((const void*)mega, hipFuncAttributeMaxDynamicSharedMemorySize, LDS_BYTES) != hipSuccess) { fprintf(stderr, "kernel_launch: hipFuncSetAttribute failed\n"); grid = -1; return; }
        int dev = 0, cus = 0, per_cu = 0;
        hipGetDevice(&dev); hipDeviceGetAttribute(&cus, hipDeviceAttributeMultiprocessorCount, dev);
        hipOccupancyMaxActiveBlocksPerMultiprocessor(&per_cu, (const void*)mega, 512, LDS_BYTES);
        if (per_cu < 1) { fprintf(stderr, "kernel_launch: occupancy query gives %d\n", per_cu); per_cu = 1; }
        grid = cus;
        (void)hipGetLastError();
    }
    if (grid < 0) return;
    if (hipMemsetAsync((char*)d_ws + OFF_BAR, 0, XCD_BAR_WORDS * 4, stream) != hipSuccess) { fprintf(stderr, "kernel_launch: memset failed\n"); return; }
    Args a{};
    const float** ap = (const float**)&a;
    for (int i = 0; i < 27; ++i) ap[i] = (const float*)d_in[i];
    a.out = (float*)d_out; a.ws = (unsigned char*)d_ws;
#if ONE_LAUNCH
    a.ph_lo = 0; a.ph_hi = NPHASE;
    void* args[] = {&a};
    hipError_t e = hipLaunchCooperativeKernel((const void*)mega, dim3(grid), dim3(512), args, LDS_BYTES, stream);
    if (e != hipSuccess) fprintf(stderr, "cooperative launch failed: %s (grid %d)\n", hipGetErrorString(e), grid);
#else
    for (int p = 0; p < NPHASE; ++p) { a.ph_lo = p; a.ph_hi = p + 1; hipLaunchKernelGGL(mega, dim3(grid), dim3(512), LDS_BYTES, stream, a); }
#endif
}
```
